# Optimizing an MI355X kernel written in HIP

```python
import jax, jax.numpy as jnp
from jax import lax
import numpy as np

D_MODEL = 1024
BATCH = 16
SEQ = 2048
DEPTH = 1

GRID_W = 64
D_FF = 2816
EPS = 1e-6
GLA_HEADS = 4
GLA_DK = 128
GLA_DV = 256
GLA_RANK = 16
GLA_TAU = 16.0
GLA_CHUNK = 64
ATT_Q_HEADS = 8
ATT_KV_HEADS = 2
ATT_HEAD_DIM = 128
ATT_BLOCK = 128
ROPE_THETA = 10000.0
GLA_KEY_W = GLA_HEADS * GLA_DK
GLA_VAL_W = GLA_HEADS * GLA_DV
ATT_Q_W = ATT_Q_HEADS * ATT_HEAD_DIM
ATT_KV_W = ATT_KV_HEADS * ATT_HEAD_DIM
IN_SPLITS = (GLA_KEY_W, GLA_KEY_W, GLA_VAL_W, GLA_VAL_W, GLA_RANK, GLA_RANK,
             ATT_Q_W, ATT_KV_W, ATT_KV_W, D_MODEL, D_MODEL)
N_IN = sum(IN_SPLITS)
IN_OFFSETS = tuple(int(s) for s in np.cumsum(IN_SPLITS)[:-1])

kernel_name = "hybrid_gla_axial_gqa_macaron_encoder"


def _rmsnorm(x, g):
    x32 = x.astype(jnp.float32)
    y = x32 * lax.rsqrt(jnp.mean(x32 * x32, axis=-1, keepdims=True) + EPS)
    return (y * g.astype(jnp.float32)).astype(x.dtype)


def _swiglu(h, w_in, w_out):
    gate, up = jnp.split(h @ w_in, 2, axis=-1)
    return (jax.nn.silu(gate) * up) @ w_out


def _heads(t, n):
    b, l, _ = t.shape
    return t.reshape(b, l, n, -1).transpose(0, 2, 1, 3)


def _gla_direction(q, k, v, g, strict):
    B, H, L, dk = q.shape
    dv = v.shape[-1]
    C = GLA_CHUNK
    n = L // C

    def to_chunks(t):
        return t.reshape(B, H, n, C, t.shape[-1]).transpose(2, 0, 1, 3, 4)

    idx = jnp.arange(C)
    mask = (idx[:, None] > idx[None, :]) if strict else (idx[:, None] >= idx[None, :])

    def step(S, inp):
        qi, ki, vi, gi = inp
        b = jnp.cumsum(gi, axis=-2)
        b_last = b[..., -1:, :]
        o_inter = jnp.einsum('bhcd,bhde->bhce', qi * jnp.exp(b), S)
        rel = jnp.where(mask[:, :, None], b[..., :, None, :] - b[..., None, :, :], -jnp.inf)
        scores = jnp.einsum('bhid,bhjd,bhijd->bhij', qi, ki, jnp.exp(rel))
        o_intra = jnp.einsum('bhij,bhje->bhie', scores, vi)
        S_new = (jnp.exp(b_last[..., 0, :])[..., None] * S
                 + jnp.einsum('bhjd,bhje->bhde', ki * jnp.exp(b_last - b), vi))
        return S_new, o_inter + o_intra

    S0 = jnp.zeros((B, H, dk, dv), jnp.float32)
    _, o = lax.scan(step, S0, (to_chunks(q), to_chunks(k), to_chunks(v), to_chunks(g)))
    return o.transpose(1, 2, 0, 3, 4).reshape(B, H, L, dv)


def _axial_rope_tables(L):
    rows = L // GRID_W
    row_pos = jnp.repeat(jnp.arange(rows), GRID_W).astype(jnp.float32)
    col_pos = jnp.tile(jnp.arange(GRID_W), rows).astype(jnp.float32)
    half = ATT_HEAD_DIM // 2
    inv_freq = ROPE_THETA ** (-jnp.arange(0, half, 2, dtype=jnp.float32) / half)
    ang_r = row_pos[:, None] * inv_freq
    ang_c = col_pos[:, None] * inv_freq
    return jnp.cos(ang_r), jnp.sin(ang_r), jnp.cos(ang_c), jnp.sin(ang_c)


def _rot_half(x, cos, sin):
    x1, x2 = jnp.split(x, 2, axis=-1)
    c, s = cos[:, None, :], sin[:, None, :]
    return jnp.concatenate([x1 * c - x2 * s, x2 * c + x1 * s], axis=-1)


def _axial_rope(x, tables):
    cos_r, sin_r, cos_c, sin_c = tables
    x32 = x.astype(jnp.float32)
    xr, xc = jnp.split(x32, 2, axis=-1)
    out = jnp.concatenate([_rot_half(xr, cos_r, sin_r), _rot_half(xc, cos_c, sin_c)], axis=-1)
    return out.astype(x.dtype)


def _block_attention(q, k, v):
    B, Hk, G, L, hd = q.shape
    nb = L // ATT_BLOCK
    qb = q.reshape(B, Hk, G, nb, ATT_BLOCK, hd).transpose(3, 0, 1, 2, 4, 5)
    scale = hd ** -0.5

    def one(qi):
        s = jnp.einsum('bkgqd,bksd->bkgqs', qi, k).astype(jnp.float32) * scale
        p = jax.nn.softmax(s, axis=-1).astype(v.dtype)
        return jnp.einsum('bkgqs,bksd->bkgqd', p, v)

    o = lax.map(one, qb)
    return o.transpose(1, 2, 3, 0, 4, 5).reshape(B, Hk, G, L, hd)


def _token_mixers(u, w_in, up_f, bias_f, up_b, bias_b, gla_out_g, w_branch_a,
                  q_norm_g, k_norm_g, w_branch_b, w_out):
    B, L, _ = u.shape
    (gq, gk, gv, gr, za_f, za_b, aq, ak, av, ga, gb) = jnp.split(u @ w_in, IN_OFFSETS, axis=-1)

    log_a_f = jax.nn.log_sigmoid((za_f @ up_f + bias_f).astype(jnp.float32)) / GLA_TAU
    log_a_b = jax.nn.log_sigmoid((za_b @ up_b + bias_b).astype(jnp.float32)) / GLA_TAU
    q_h = _heads(gq, GLA_HEADS) * (GLA_DK ** -0.5)
    k_h = _heads(gk, GLA_HEADS)
    v_h = _heads(gv, GLA_HEADS)
    gf_h = _heads(log_a_f, GLA_HEADS)
    gb_h = _heads(log_a_b, GLA_HEADS)
    o_fwd = _gla_direction(q_h, k_h, v_h, gf_h, strict=False)
    flip = lambda t: t[..., ::-1, :]
    o_bwd = flip(_gla_direction(flip(q_h), flip(k_h), flip(v_h), flip(gb_h), strict=True))
    o = o_fwd + o_bwd
    o = _rmsnorm(o, gla_out_g[:, None, :]).astype(u.dtype)
    o = o.transpose(0, 2, 1, 3).reshape(B, L, GLA_VAL_W)
    y_a = (o * jax.nn.silu(gr)) @ w_branch_a

    tables = _axial_rope_tables(L)
    qa = aq.reshape(B, L, ATT_Q_HEADS, ATT_HEAD_DIM)
    ka = ak.reshape(B, L, ATT_KV_HEADS, ATT_HEAD_DIM)
    va = av.reshape(B, L, ATT_KV_HEADS, ATT_HEAD_DIM)
    qa = _axial_rope(_rmsnorm(qa, q_norm_g), tables)
    ka = _axial_rope(_rmsnorm(ka, k_norm_g), tables)
    group = ATT_Q_HEADS // ATT_KV_HEADS
    qa = qa.transpose(0, 2, 1, 3).reshape(B, ATT_KV_HEADS, group, L, ATT_HEAD_DIM)
    ka = ka.transpose(0, 2, 1, 3)
    va = va.transpose(0, 2, 1, 3)
    ob = _block_attention(qa, ka, va)
    ob = ob.reshape(B, ATT_Q_HEADS, L, ATT_HEAD_DIM).transpose(0, 2, 1, 3).reshape(B, L, ATT_Q_W)
    y_b = ob @ w_branch_b

    merged = jax.nn.sigmoid(ga) * y_a + jax.nn.sigmoid(gb) * y_b
    return merged @ w_out


def setup_inputs(seed: int = 0) -> dict:
    key = jax.random.key(seed)
    ks = iter(jax.random.split(key, 32))
    f32 = jnp.float32

    def w(shape, fan_in):
        return jax.random.normal(next(ks), shape, f32) * (fan_in ** -0.5)

    def gain(shape):
        return 1.0 + 0.05 * jax.random.normal(next(ks), shape, f32)

    def bias(shape):
        return 0.1 * jax.random.normal(next(ks), shape, f32)

    Dp = DEPTH
    return {
        "x": jax.random.normal(next(ks), (BATCH, SEQ, D_MODEL), f32),
        "ffn1_pre_g": gain((Dp, D_MODEL)),
        "ffn1_w_in": w((Dp, D_MODEL, 2 * D_FF), D_MODEL),
        "ffn1_w_out": w((Dp, D_FF, D_MODEL), D_FF),
        "ffn1_post_g": gain((Dp, D_MODEL)),
        "mix_pre_g": gain((Dp, D_MODEL)),
        "w_in": w((Dp, D_MODEL, N_IN), D_MODEL),
        "gla_decay_up_f": w((Dp, GLA_RANK, GLA_KEY_W), GLA_RANK),
        "gla_decay_bias_f": bias((Dp, GLA_KEY_W)),
        "gla_decay_up_b": w((Dp, GLA_RANK, GLA_KEY_W), GLA_RANK),
        "gla_decay_bias_b": bias((Dp, GLA_KEY_W)),
        "gla_out_g": gain((Dp, GLA_HEADS, GLA_DV)),
        "w_branch_a": w((Dp, GLA_VAL_W, D_MODEL), GLA_VAL_W),
        "att_q_norm_g": gain((Dp, ATT_HEAD_DIM)),
        "att_k_norm_g": gain((Dp, ATT_HEAD_DIM)),
        "w_branch_b": w((Dp, ATT_Q_W, D_MODEL), ATT_Q_W),
        "w_out": w((Dp, D_MODEL, D_MODEL), D_MODEL),
        "mix_post_g": gain((Dp, D_MODEL)),
        "ffn2_pre_g": gain((Dp, D_MODEL)),
        "ffn2_w_in": w((Dp, D_MODEL, 2 * D_FF), D_MODEL),
        "ffn2_w_out": w((Dp, D_FF, D_MODEL), D_FF),
        "ffn2_post_g": gain((Dp, D_MODEL)),
    }


def reference(x, ffn1_pre_g, ffn1_w_in, ffn1_w_out, ffn1_post_g, mix_pre_g, w_in,
              gla_decay_up_f, gla_decay_bias_f, gla_decay_up_b, gla_decay_bias_b,
              gla_out_g, w_branch_a, att_q_norm_g, att_k_norm_g, w_branch_b, w_out,
              mix_post_g, ffn2_pre_g, ffn2_w_in, ffn2_w_out, ffn2_post_g):
    h = x
    for l in range(DEPTH):
        f1 = _swiglu(_rmsnorm(h, ffn1_pre_g[l]), ffn1_w_in[l], ffn1_w_out[l])
        h = h + 0.5 * _rmsnorm(f1, ffn1_post_g[l])
        m = _token_mixers(_rmsnorm(h, mix_pre_g[l]), w_in[l],
                          gla_decay_up_f[l], gla_decay_bias_f[l],
                          gla_decay_up_b[l], gla_decay_bias_b[l],
                          gla_out_g[l], w_branch_a[l],
                          att_q_norm_g[l], att_k_norm_g[l], w_branch_b[l], w_out[l])
        h = h + _rmsnorm(m, mix_post_g[l])
        f2 = _swiglu(_rmsnorm(h, ffn2_pre_g[l]), ffn2_w_in[l], ffn2_w_out[l])
        h = h + 0.5 * _rmsnorm(f2, ffn2_post_g[l])
    return h
```

```cpp
#include <hip/hip_runtime.h>
#include <hip/hip_bf16.h>
#include <hip/hip_cooperative_groups.h>
#include <cstdio>
#include <cstdint>
namespace cg = cooperative_groups;

#ifndef MK_PER_PHASE
#define MK_PER_PHASE 0
#endif

namespace pg8 {
#define PG8_LAS __attribute__((address_space(3)))
typedef unsigned short bf16_t;
typedef short bf16x8 __attribute__((ext_vector_type(8)));
typedef float f32x4 __attribute__((ext_vector_type(4)));
typedef unsigned u32x4 __attribute__((ext_vector_type(4)));
constexpr int BM = 256, BK = 64, HALF = 128, HTB = HALF * BK * 2  , STAGE_BYTES = 8 * HTB, NXCD = 8, WGM = 8;

__host__ __device__ __forceinline__ int lds_byte(int r, int c) { const int st = (r >> 4) * 2 + (c >> 5), rr = r & 15, cc = c & 31, ob = rr * 64 + cc * 2; return st * 1024 + (ob ^ (((ob >> 9) & 1) << 5)); }
__host__ __device__ __forceinline__ void stage_rc(int b, int& R, int& C) { const int st = b / 1024, sb = b % 1024, swz = sb ^ (((sb >> 9) & 1) << 5); R = (st >> 1) * 16 + swz / 64; C = (st & 1) * 32 + (swz % 64) / 2; }
__host__ __device__ __forceinline__ int perm32(int rho) { const int n = rho >> 4, i = rho & 15; return 8 * (i >> 2) + 4 * n + (i & 3); }

struct Unit { int pm, pn; };
struct Gemm { const bf16_t* A; const bf16_t* Bt; int M, N, K; };

struct StaticOrder {
    int nM, nN, nwg, G, c;
    __host__ __device__ void init(int M, int N, int G_, int c_) { nM = M / BM; nN = N / BM; nwg = nM * nN; G = G_; c = c_; }
    __host__ __device__ bool next(int i, Unit& u) const {
        const long L = (long)i * G + c; if (L >= nwg) return false;
        int wgid = (int)L; { const int q = nwg / NXCD, r = nwg % NXCD, xcd = wgid % NXCD, off = wgid / NXCD; wgid = (xcd < r ? xcd * (q + 1) : r * (q + 1) + (xcd - r) * q) + off; }
        const int nig = WGM * nN, gid = wgid / nig, fm = gid * WGM, gsz = (nM - fm) < WGM ? (nM - fm) : WGM;
        u.pm = fm + ((wgid % nig) % gsz); u.pn = (wgid % nig) / gsz; return true;
    }
    __device__ __forceinline__ void a_ready(const Unit&) const {}
    __device__ __forceinline__ void done(const Unit&) const {}
};
__device__ __forceinline__ unsigned cvt_pk_bf16(float lo, float hi) { unsigned r; asm volatile("v_cvt_pk_bf16_f32 %0, %1, %2" : "=v"(r) : "v"(lo), "v"(hi)); return r; }
typedef float f32x2 __attribute__((ext_vector_type(2)));

__device__ __forceinline__ float fsigmoid(float x) { return __builtin_amdgcn_rcpf(1.0f + __expf(-x)); }
__device__ __forceinline__ float fsilu(float x) { return x * fsigmoid(x); }
__device__ __forceinline__ f32x4 sigmoid4(f32x4 x) {
    f32x4 d;
#pragma unroll
    for (int j = 0; j < 4; ++j) d[j] = 1.0f + __expf(-fmaxf(x[j], -20.0f));
    const float p01 = d[0] * d[1], p23 = d[2] * d[3], r = __builtin_amdgcn_rcpf(p01 * p23), r01 = r * p23, r23 = r * p01;
    return (f32x4){r01 * d[1], r01 * d[0], r23 * d[3], r23 * d[2]};
}
__device__ __forceinline__ float flogsig16(float x) { return (fminf(x, 0.f) - __logf(1.0f + __expf(-fabsf(x)))) * 0.0625f; }
__device__ __forceinline__ float bf_lo(unsigned u) { return __uint_as_float(u << 16); }
__device__ __forceinline__ float bf_hi(unsigned u) { return __uint_as_float(u & 0xffff0000u); }

struct EpiAct {
    static constexpr bool PERM = true, AFTER_DRAIN = false;
    bf16_t* O; int ldc; int mode; const float* bias_f; const float* bias_b;
    __device__ __forceinline__ void operator()(const f32x4 (&acc)[2][2][4][2], const Unit& u, int wr, int wc, int fr, int fq) const {
        int act = 0; const float* bias = nullptr;
        if (mode == 1) { if (u.pn >= 8 && u.pn < 12) act = 1; else if (u.pn >= 12) { act = 3; bias = (u.pn >= 14) ? bias_b + (u.pn - 14) * 256 : bias_f + (u.pn - 12) * 256; } }
        else if (mode == 2) { if (u.pn >= 6) act = 2; }
        const int row0 = u.pm * BM + wr * 64 + fr, col0 = u.pn * BM + wc * 32 + 8 * fq, bcol0 = wc * 32 + 8 * fq;
        f32x4 bv[2][2];
#pragma unroll
        for (int bj = 0; bj < 2; ++bj)
#pragma unroll
            for (int n = 0; n < 2; ++n) bv[bj][n] = bias ? *(const f32x4*)(bias + bcol0 + bj * HALF + 4 * n) : (f32x4){0.f, 0.f, 0.f, 0.f};
#pragma unroll
        for (int ai = 0; ai < 2; ++ai)
#pragma unroll
            for (int m = 0; m < 4; ++m) { bf16_t* rowp = O + (size_t)(row0 + ai * HALF + m * 16) * ldc + col0;
#pragma unroll
                for (int bj = 0; bj < 2; ++bj) { f32x4 v0 = acc[ai][bj][m][0] + bv[bj][0], v1 = acc[ai][bj][m][1] + bv[bj][1];
                    if (act == 1) {
#pragma unroll
                        for (int j = 0; j < 1; ++j) { v0 = v0 * sigmoid4(v0); v1 = v1 * sigmoid4(v1); } }
                    else if (act == 2) {
#pragma unroll
                        for (int j = 0; j < 1; ++j) { v0 = sigmoid4(v0); v1 = sigmoid4(v1); } }
                    else if (act == 3) {
#pragma unroll
                        for (int j = 0; j < 4; ++j) { v0[j] = flogsig16(v0[j]); v1[j] = flogsig16(v1[j]); } }
                    u32x4 w; w.x = cvt_pk_bf16(v0[0], v0[1]); w.y = cvt_pk_bf16(v0[2], v0[3]); w.z = cvt_pk_bf16(v1[0], v1[1]); w.w = cvt_pk_bf16(v1[2], v1[3]);
                    *(u32x4*)(rowp + bj * HALF) = w; } }
    }
};
struct EpiSwiglu {
    static constexpr bool PERM = true, AFTER_DRAIN = false;
    bf16_t* O; int ldc;
    __device__ __forceinline__ void operator()(const f32x4 (&acc)[2][2][4][2], const Unit& u, int wr, int wc, int fr, int fq) const {
        const int row0 = u.pm * BM + wr * 64 + fr, col0 = u.pn * HALF + wc * 32 + 8 * fq;
#pragma unroll
        for (int ai = 0; ai < 2; ++ai)
#pragma unroll
            for (int m = 0; m < 4; ++m) { bf16_t* rowp = O + (size_t)(row0 + ai * HALF + m * 16) * ldc + col0;
                f32x4 v0, v1;
#pragma unroll
                for (int j = 0; j < 1; ++j) { v0 = acc[ai][0][m][0] * sigmoid4(acc[ai][0][m][0]) * acc[ai][1][m][0]; v1 = acc[ai][0][m][1] * sigmoid4(acc[ai][0][m][1]) * acc[ai][1][m][1]; }
                u32x4 w; w.x = cvt_pk_bf16(v0[0], v0[1]); w.y = cvt_pk_bf16(v0[2], v0[3]); w.z = cvt_pk_bf16(v1[0], v1[1]); w.w = cvt_pk_bf16(v1[2], v1[3]);
                *(u32x4*)rowp = w; }
    }
};
template <bool ACCUM> struct EpiGate {
    static constexpr bool PERM = true, AFTER_DRAIN = false;
    bf16_t* O; int ldc; const bf16_t* G; int ldg;
    __device__ __forceinline__ void operator()(const f32x4 (&acc)[2][2][4][2], const Unit& u, int wr, int wc, int fr, int fq) const {
        const int row0 = u.pm * BM + wr * 64 + fr, col0 = u.pn * BM + wc * 32 + 8 * fq;
#pragma unroll
        for (int ai = 0; ai < 2; ++ai)
#pragma unroll
            for (int m = 0; m < 4; ++m) { const size_t r = (size_t)(row0 + ai * HALF + m * 16); bf16_t* rowp = O + r * ldc + col0; const bf16_t* gp = G + r * ldg + col0;
#pragma unroll
                for (int bj = 0; bj < 2; ++bj) { const u32x4 gw = *(const u32x4*)(gp + bj * HALF);
                    f32x4 v0 = acc[ai][bj][m][0], v1 = acc[ai][bj][m][1];
                    v0[0] *= bf_lo(gw.x); v0[1] *= bf_hi(gw.x); v0[2] *= bf_lo(gw.y); v0[3] *= bf_hi(gw.y);
                    v1[0] *= bf_lo(gw.z); v1[1] *= bf_hi(gw.z); v1[2] *= bf_lo(gw.w); v1[3] *= bf_hi(gw.w);
                    if (ACCUM) { const u32x4 pw = *(const u32x4*)(rowp + bj * HALF);
                        v0[0] += bf_lo(pw.x); v0[1] += bf_hi(pw.x); v0[2] += bf_lo(pw.y); v0[3] += bf_hi(pw.y);
                        v1[0] += bf_lo(pw.z); v1[1] += bf_hi(pw.z); v1[2] += bf_lo(pw.w); v1[3] += bf_hi(pw.w); }
                    u32x4 w; w.x = cvt_pk_bf16(v0[0], v0[1]); w.y = cvt_pk_bf16(v0[2], v0[3]); w.z = cvt_pk_bf16(v1[0], v1[1]); w.w = cvt_pk_bf16(v1[2], v1[3]);
                    *(u32x4*)(rowp + bj * HALF) = w; } }
    }
};

template <class Epi, class Sched>
__device__ __forceinline__ void gemm_phase(PG8_LAS unsigned char* lds, const Gemm g, const Sched& S, const Epi& E) {
    int tid_ = threadIdx.x; asm volatile("" : "+v"(tid_));
    const int tid = tid_, wid = __builtin_amdgcn_readfirstlane(tid >> 6), lane = tid & 63, wr = wid >> 2, wc = wid & 3, fr = lane & 15, fq = lane >> 4;
    const int K = g.K, nt = K / BK;
    unsigned voffA[2], voffB[2];
#pragma unroll
    for (int i = 0; i < 2; ++i) { int R, C; stage_rc(tid * 16 + i * 8192, R, C); const int Rb = Epi::PERM ? ((R & ~31) + perm32(R & 31)) : R;
        voffA[i] = (unsigned)(R * K + C) * 2u; voffB[i] = (unsigned)(Rb * K + C) * 2u; }
    const size_t kstep = (size_t)(BK * 2);
    const size_t hstep = (size_t)HALF * K * 2;
    const size_t tstep = 2 * hstep;
    const unsigned ldsw = (unsigned)wid * 1024u;
    const int aoff = lds_byte(wr * 64 + fr, fq * 8), boff = lds_byte(wc * 32 + fr, fq * 8);
#define PG8_SA(b, h) (((b) * 2 + (h)) * HTB)
#define PG8_SB(b, h) ((4 + (b) * 2 + (h)) * HTB)
#define PG8_STAGE(bufoff, gbase, voff) do { _Pragma("unroll") for (int _i = 0; _i < 2; ++_i) \
        __builtin_amdgcn_global_load_lds((const unsigned*)((const char*)(gbase) + (voff)[_i]), (PG8_LAS unsigned*)(lds + (bufoff) + ldsw + _i * 8192), 16, 0, 0); } while (0)
#define PG8_LDA(dst, b, h) do { _Pragma("unroll") for (int m = 0; m < 4; ++m) _Pragma("unroll") for (int k = 0; k < 2; ++k) dst[m][k] = *(const PG8_LAS bf16x8*)(lds + PG8_SA(b, h) + aoff + m * 2048 + k * 1024); } while (0)
#define PG8_LDB(dst, b, h) do { _Pragma("unroll") for (int n = 0; n < 2; ++n) _Pragma("unroll") for (int k = 0; k < 2; ++k) dst[n][k] = *(const PG8_LAS bf16x8*)(lds + PG8_SB(b, h) + boff + n * 2048 + k * 1024); } while (0)
#define PG8_MMA(ai, bj, At, Bt) do { __builtin_amdgcn_s_setprio(1); _Pragma("unroll") for (int m = 0; m < 4; ++m) _Pragma("unroll") for (int n = 0; n < 2; ++n) _Pragma("unroll") for (int k = 0; k < 2; ++k) \
        acc[ai][bj][m][n] = __builtin_amdgcn_mfma_f32_16x16x32_bf16(Bt[n][k], At[m][k], acc[ai][bj][m][n], 0, 0, 0); __builtin_amdgcn_s_setprio(0); } while (0)
#define PG8_WAIT_V(n) asm volatile("s_waitcnt vmcnt(" #n ")" ::: "memory")
#define PG8_WAIT_L(n) asm volatile("s_waitcnt lgkmcnt(" #n ")" ::: "memory")
#define PG8_BAR __builtin_amdgcn_s_barrier()
#define PG8_SCHED __builtin_amdgcn_sched_barrier(0)
    Unit cur, nxt; int ui = 0;
    if (!S.next(0, cur)) return;
    f32x4 acc[2][2][4][2];
#pragma unroll
    for (int a = 0; a < 2; ++a)
#pragma unroll
        for (int b = 0; b < 2; ++b)
#pragma unroll
            for (int m = 0; m < 4; ++m)
#pragma unroll
                for (int n = 0; n < 2; ++n) acc[a][b][m][n] = (f32x4){0.f, 0.f, 0.f, 0.f};
    bf16x8 At[4][2], B0[2][2], B1[2][2];
    const char* cA = (const char*)g.A + (size_t)cur.pm * tstep; const char* cB = (const char*)g.Bt + (size_t)cur.pn * tstep;
    S.a_ready(cur);
    PG8_STAGE(PG8_SB(0, 0), cB, voffB); PG8_STAGE(PG8_SA(0, 0), cA, voffA); PG8_STAGE(PG8_SB(0, 1), cB + hstep, voffB); PG8_STAGE(PG8_SA(0, 1), cA + hstep, voffA);
    if (wr == 1) PG8_BAR;
    PG8_WAIT_V(4); PG8_BAR;
    PG8_STAGE(PG8_SB(1, 0), cB + kstep, voffB); PG8_STAGE(PG8_SA(1, 0), cA + kstep, voffA); PG8_STAGE(PG8_SB(1, 1), cB + hstep + kstep, voffB);
    PG8_WAIT_V(6); PG8_BAR;
    for (;;) {
        const bool has_next = S.next(ui + 1, nxt);
        const char* nA = has_next ? (const char*)g.A + (size_t)nxt.pm * tstep : cA; const char* nB = has_next ? (const char*)g.Bt + (size_t)nxt.pn * tstep : cB;
        for (int t = 0; t < nt; t += 2) {
            const bool last = (t == nt - 2);
            const char* a1 = cA + (size_t)(t + 1) * kstep;
            const char* a2 = last ? nA : cA + (size_t)(t + 2) * kstep; const char* b2 = last ? nB : cB + (size_t)(t + 2) * kstep;
            const char* a3 = a2 + kstep; const char* b3 = b2 + kstep;
            if (last && has_next) S.a_ready(nxt);
            PG8_LDB(B0, 0, 0); PG8_SCHED; PG8_LDA(At, 0, 0); PG8_STAGE(PG8_SA(1, 1), a1 + hstep, voffA);
            PG8_WAIT_L(8); PG8_BAR; PG8_WAIT_L(0); PG8_MMA(0, 0, At, B0); PG8_BAR; PG8_SCHED;
            PG8_LDB(B1, 0, 1); PG8_STAGE(PG8_SB(0, 0), b2, voffB);
            PG8_BAR; PG8_WAIT_L(0); PG8_MMA(0, 1, At, B1); PG8_BAR;
            PG8_LDA(At, 0, 1); PG8_STAGE(PG8_SA(0, 0), a2, voffA);
            PG8_BAR; PG8_WAIT_L(0); PG8_MMA(1, 0, At, B0); PG8_BAR; PG8_SCHED;
            PG8_STAGE(PG8_SB(0, 1), b2 + hstep, voffB);
            PG8_WAIT_V(6); PG8_BAR; PG8_MMA(1, 1, At, B1); PG8_BAR;
            PG8_LDB(B0, 1, 0); PG8_SCHED; PG8_LDA(At, 1, 0); PG8_STAGE(PG8_SA(0, 1), a2 + hstep, voffA);
            PG8_WAIT_L(8); PG8_BAR; PG8_WAIT_L(0); PG8_MMA(0, 0, At, B0); PG8_BAR; PG8_SCHED;
            PG8_LDB(B1, 1, 1); PG8_STAGE(PG8_SB(1, 0), b3, voffB);
            PG8_BAR; PG8_WAIT_L(0); PG8_MMA(0, 1, At, B1); PG8_BAR;
            PG8_LDA(At, 1, 1); PG8_STAGE(PG8_SA(1, 0), a3, voffA);
            PG8_BAR; PG8_WAIT_L(0); PG8_MMA(1, 0, At, B0); PG8_BAR; PG8_SCHED;
            PG8_STAGE(PG8_SB(1, 1), b3 + hstep, voffB);
            PG8_WAIT_V(6); PG8_BAR; PG8_MMA(1, 1, At, B1); PG8_BAR;
        }
        if constexpr (!Epi::AFTER_DRAIN) { E(acc, cur, wr, wc, fr, fq); S.done(cur); }
        if (!has_next) break;
#pragma unroll
        for (int a = 0; a < 2; ++a)
#pragma unroll
            for (int b = 0; b < 2; ++b)
#pragma unroll
                for (int m = 0; m < 4; ++m)
#pragma unroll
                    for (int n = 0; n < 2; ++n) acc[a][b][m][n] = (f32x4){0.f, 0.f, 0.f, 0.f};
        cur = nxt; cA = nA; cB = nB; ++ui;
    }
    PG8_WAIT_V(0);
    if (wr == 0) PG8_BAR;
    PG8_BAR;
    if constexpr (Epi::AFTER_DRAIN) { E.fused(acc, cur, wr, wc, fr, fq, lds, wid, lane); S.done(cur); }
#undef PG8_SA
#undef PG8_SB
#undef PG8_STAGE
#undef PG8_LDA
#undef PG8_LDB
#undef PG8_MMA
#undef PG8_WAIT_V
#undef PG8_WAIT_L
#undef PG8_BAR
#undef PG8_SCHED
}
}

namespace attn {
using bf16 = __hip_bfloat16;
constexpr int   D = 128, NW = 8, QBLK = 32, KVBLK = 64;
constexpr float SCALE = 0.088388347648318440f;
constexpr float THR = 8.f;
constexpr int SDEPTH = 2;
constexpr int LDQ = 3584, LDK = 3584, LDO = 1024;
constexpr size_t SHM_V = KVBLK * D * 2, SHM_K = KVBLK * D * 2, SHM_ATTN = 2 * SHM_V + 2 * SHM_K + NW * 64 * 4;
__device__ __forceinline__ unsigned short f2bf_rne(float f) { unsigned u = __float_as_uint(f); u += 0x7FFFu + ((u >> 16) & 1u); return (unsigned short)(u >> 16); }
using bf16x8 = __attribute__((ext_vector_type(8))) short;
using s16x4  = __attribute__((ext_vector_type(4))) short;
using f32x16 = __attribute__((ext_vector_type(16))) float;
using f32x8  = __attribute__((ext_vector_type(8))) float;
using u32x4  = __attribute__((ext_vector_type(4))) unsigned;
#define KSWZ(row, colB) ((row) * 256 + ((colB) ^ (((row) & 7) << 4)))
#define SBAR() __builtin_amdgcn_sched_barrier(0)
__device__ __forceinline__ int crow(int r, int hi) { return (r & 3) + 8 * (r >> 2) + 4 * hi; }
__device__ __forceinline__ unsigned cvtpk(float lo, float hi) {
  unsigned r; asm volatile("v_cvt_pk_bf16_f32 %0, %1, %2" : "=v"(r) : "v"(lo), "v"(hi)); return r;
}
template <typename TIn> struct Stage;
template <> struct Stage<bf16>  { using T = bf16x8;
  __device__ static __forceinline__ T ld8(const bf16* p) { return *reinterpret_cast<const bf16x8*>(p); }
  __device__ static __forceinline__ bf16x8 tobf(T x) { return x; } };
template <> struct Stage<float> { using T = f32x8;
  __device__ static __forceinline__ T ld8(const float* p) { return *reinterpret_cast<const f32x8*>(p); }
  __device__ static __forceinline__ bf16x8 tobf(T x) {
    u32x4 w = {cvtpk(x[0], x[1]), cvtpk(x[2], x[3]), cvtpk(x[4], x[5]), cvtpk(x[6], x[7])}; return *reinterpret_cast<bf16x8*>(&w); } };

__device__ __forceinline__ void partialSM(f32x16& p0, f32x16& p1, float& m_reg, float& mn, float& alpha) {
  constexpr float C = SCALE * 1.4426950408889634f;
  float pmax = p0[0]; for (int r = 1; r < 16; ++r) pmax = fmaxf(pmax, p0[r]); for (int r = 0; r < 16; ++r) pmax = fmaxf(pmax, p1[r]);
  { auto rr = __builtin_amdgcn_permlane32_swap(__float_as_uint(pmax), __float_as_uint(pmax), false, false);
    pmax = fmaxf(__uint_as_float(rr[0]), __uint_as_float(rr[1])); }
  if (__builtin_expect(__all(pmax - m_reg <= THR / SCALE), 1)) { mn = m_reg; alpha = 1.f; }
  else { mn = fmaxf(m_reg, pmax); alpha = __builtin_amdgcn_exp2f((m_reg - mn) * C); m_reg = mn; }
  float mnC = -mn * C;
  for (int r = 0; r < 16; ++r) p0[r] = fmaf(p0[r], C, mnC); for (int r = 0; r < 16; ++r) p1[r] = fmaf(p1[r], C, mnC);
  for (int r = 0; r < 16; ++r) p0[r] = __builtin_amdgcn_exp2f(p0[r]);
}
__device__ __forceinline__ void finishSM(f32x16& p0, f32x16& p1, float alpha, float& l_reg, bf16x8& pa0, bf16x8& pa1, bf16x8& pa2, bf16x8& pa3) {
  for (int r = 0; r < 16; ++r) p1[r] = __builtin_amdgcn_exp2f(p1[r]);
  float ps = 0; for (int r = 0; r < 16; ++r) ps += p0[r]; for (int r = 0; r < 16; ++r) ps += p1[r];
  { auto rr = __builtin_amdgcn_permlane32_swap(__float_as_uint(ps), __float_as_uint(ps), false, false);
    ps = __uint_as_float(rr[0]) + __uint_as_float(rr[1]); }
  l_reg = l_reg * alpha + ps;
#define PK4(P, BASE, OUT) do { unsigned a0 = cvtpk(P[BASE + 0], P[BASE + 1]), a1 = cvtpk(P[BASE + 2], P[BASE + 3]);   \
    unsigned b0 = cvtpk(P[BASE + 4], P[BASE + 5]), b1 = cvtpk(P[BASE + 6], P[BASE + 7]);                              \
    auto r0 = __builtin_amdgcn_permlane32_swap(a0, b0, false, false); auto r1 = __builtin_amdgcn_permlane32_swap(a1, b1, false, false); \
    u32x4 w = {r0[0], r1[0], r0[1], r1[1]}; OUT = *reinterpret_cast<bf16x8*>(&w); } while (0)
  PK4(p0, 0, pa0); PK4(p0, 8, pa1); PK4(p1, 0, pa2); PK4(p1, 8, pa3);
#undef PK4
}
__device__ __forceinline__ void qkt(f32x16& p0, f32x16& p1, const bf16* Ks, const bf16x8* qr, int r32, int hi) {
  p0 = f32x16{}; p1 = f32x16{};
  for (int d0 = 0; d0 < 8; ++d0) { int cb = (d0 * 16 + hi * 8) * 2;
    bf16x8 b0 = *reinterpret_cast<const bf16x8*>((const char*)Ks + KSWZ(r32, cb));
    bf16x8 b1 = *reinterpret_cast<const bf16x8*>((const char*)Ks + KSWZ(32 + r32, cb));
    p0 = __builtin_amdgcn_mfma_f32_32x32x16_bf16(b0, qr[d0], p0, 0, 0, 0);
    p1 = __builtin_amdgcn_mfma_f32_32x32x16_bf16(b1, qr[d0], p1, 0, 0, 0); }
}
__device__ __forceinline__ int v_st(int k, int c) { const int kk = (k & ~0xC) | ((k & 4) << 1) | ((k & 8) >> 1); return ((kk >> 3) * 4 + (c >> 5)) * 512 + ((kk & 7) * 32 + (c & 31)) * 2; }
__device__ __forceinline__ int v_rd_base(int lane) { return ((lane & 3) << 3) | (((lane >> 2) & 3) << 6) | (((lane >> 4) & 1) << 5) | (((lane >> 5) & 1) << 8); }
constexpr int v_rd_off(int d0, int ks, int half) { return d0 * 512 + ks * 4096 + half * 2048; }
template <int OFF> __device__ __forceinline__ s16x4 tr_read(int vb) {
  s16x4 r; asm volatile("ds_read_b64_tr_b16 %0, %1 offset:%2" : "=&v"(r) : "v"(vb), "i"(OFF) : "memory"); return r;
}
template <int D0> __device__ __forceinline__ void pv_one(f32x16& od, int vb, bf16x8 pa0, bf16x8 pa1, bf16x8 pa2, bf16x8 pa3) {
  const s16x4 l0 = tr_read<v_rd_off(D0, 0, 0)>(vb), h0 = tr_read<v_rd_off(D0, 0, 1)>(vb), l1 = tr_read<v_rd_off(D0, 1, 0)>(vb), h1 = tr_read<v_rd_off(D0, 1, 1)>(vb);
  const s16x4 l2 = tr_read<v_rd_off(D0, 2, 0)>(vb), h2 = tr_read<v_rd_off(D0, 2, 1)>(vb), l3 = tr_read<v_rd_off(D0, 3, 0)>(vb), h3 = tr_read<v_rd_off(D0, 3, 1)>(vb);
  asm volatile("s_waitcnt lgkmcnt(0)" ::: "memory"); SBAR();
#define PK(L, H) (bf16x8){L[0], L[1], L[2], L[3], H[0], H[1], H[2], H[3]}
  od = __builtin_amdgcn_mfma_f32_32x32x16_bf16(pa0, PK(l0, h0), od, 0, 0, 0);
  od = __builtin_amdgcn_mfma_f32_32x32x16_bf16(pa1, PK(l1, h1), od, 0, 0, 0);
  od = __builtin_amdgcn_mfma_f32_32x32x16_bf16(pa2, PK(l2, h2), od, 0, 0, 0);
  od = __builtin_amdgcn_mfma_f32_32x32x16_bf16(pa3, PK(l3, h3), od, 0, 0, 0);
#undef PK
}
__device__ __forceinline__ void pv_d0(f32x16* o, int vb, bf16x8 pa0, bf16x8 pa1, bf16x8 pa2, bf16x8 pa3) {
  pv_one<0>(o[0], vb, pa0, pa1, pa2, pa3); pv_one<1>(o[1], vb, pa0, pa1, pa2, pa3); pv_one<2>(o[2], vb, pa0, pa1, pa2, pa3); pv_one<3>(o[3], vb, pa0, pa1, pa2, pa3);
}

template <typename TQ>
__device__ __forceinline__ void attn_dense_body(const TQ* __restrict__ Qb, const bf16* __restrict__ Kh, const bf16* __restrict__ Vh,
                                                unsigned short* __restrict__ Ob, int seq, char* lds, const float* __restrict__ qg, int pos0) {
  using St = Stage<bf16>; using SQ = Stage<TQ>;
  int tid_ = threadIdx.x; asm volatile("" : "+v"(tid_));
  const int tid = tid_, wid = tid >> 6, lane = tid & 63, r32 = lane & 31, hi = lane >> 5;
  bf16* V_lds = (bf16*)lds; bf16* K_lds = (bf16*)(lds + 2 * SHM_V);
  float* ws = (float*)(lds + 2 * SHM_V + 2 * SHM_K) + wid * 64; float* li_l = ws; float* al_l = ws + 32;
  float m_reg = -1e30f, l_reg = 0; f32x16 o[4] = {}; bf16x8 qr[8];
  const TQ* Qw = Qb + (long)(wid * QBLK + r32) * LDQ + hi * 8;
#pragma unroll
  for (int d0 = 0; d0 < 8; ++d0) qr[d0] = SQ::tobf(SQ::ld8(Qw + d0 * 16));
  {
#define QF(d0, jj) __uint_as_float(((unsigned)(unsigned short)qr[d0][jj]) << 16)
    int hi2 = hi; asm volatile("" : "+v"(hi2));
    const float* qg2 = qg; asm volatile("" : "+s"(qg2));
    float ss = 0.f;
#pragma unroll
    for (int d0 = 0; d0 < 8; ++d0)
#pragma unroll
      for (int jj = 0; jj < 8; ++jj) { const float x = QF(d0, jj); ss += x * x; }
    ss += __shfl_xor(ss, 32);
    const float ri = rsqrtf(ss * (1.0f / 128.0f) + 1e-6f);
    const int pos = pos0 + wid * QBLK + r32; const float prow = (float)(pos >> 6), pcol = (float)(pos & 63);
    u32x4 qv[8];
#pragma unroll
    for (int d0 = 0; d0 < 8; ++d0) qv[d0] = *reinterpret_cast<u32x4*>(&qr[d0]);
#pragma unroll
    for (int dd = 0; dd < 2; ++dd)
#pragma unroll
      for (int jp = 0; jp < 4; ++jp) { float o[4][2];
#pragma unroll
        for (int u = 0; u < 2; ++u) { const int jj = 2 * jp + u, e0 = 16 * dd + 8 * hi2 + jj;
          const float invf = exp2f(-(float)e0 * (13.287712379549449f / 32.0f));
          const float ar = prow * invf, ac = pcol * invf;
          const float sr_ = __sinf(ar), cr_ = __cosf(ar), sc_ = __sinf(ac), cc_ = __cosf(ac);
#define QW(d0) (u ? __uint_as_float(qv[d0][jp] & 0xffff0000u) : __uint_as_float(qv[d0][jp] << 16))
          const float a1 = QW(dd) * ri * qg2[e0], a2 = QW(dd + 2) * ri * qg2[32 + e0], b1 = QW(4 + dd) * ri * qg2[64 + e0], b2 = QW(6 + dd) * ri * qg2[96 + e0];
#undef QW
          o[0][u] = a1 * cr_ - a2 * sr_; o[1][u] = a2 * cr_ + a1 * sr_; o[2][u] = b1 * cc_ - b2 * sc_; o[3][u] = b2 * cc_ + b1 * sc_; }
        qv[dd][jp] = cvtpk(o[0][0], o[0][1]); qv[dd + 2][jp] = cvtpk(o[1][0], o[1][1]); qv[4 + dd][jp] = cvtpk(o[2][0], o[2][1]); qv[6 + dd][jp] = cvtpk(o[3][0], o[3][1]); }
#pragma unroll
    for (int d0 = 0; d0 < 8; ++d0) qr[d0] = *reinterpret_cast<bf16x8*>(&qv[d0]);
#undef QF
  }
  const int sr = tid >> 4, sc = (tid & 15) * 8, vst0 = v_st(sr, sc), vst1 = v_st(32 + sr, sc);
  const int vb0 = (int)(uintptr_t)V_lds + v_rd_base(lane);
  struct { typename St::T vs0, vs1, ks0, ks1; } sr_[SDEPTH];
#define SLOAD(i, k0) do { sr_[i].vs0 = St::ld8(&Vh[(long)((k0) + sr) * LDK + sc]); sr_[i].vs1 = St::ld8(&Vh[(long)((k0) + 32 + sr) * LDK + sc]); \
    sr_[i].ks0 = St::ld8(&Kh[(long)((k0) + sr) * LDK + sc]); sr_[i].ks1 = St::ld8(&Kh[(long)((k0) + 32 + sr) * LDK + sc]); } while (0)
#define SWRITE(b, i) do { *(bf16x8*)((char*)V_lds + (b) * SHM_V + vst0) = St::tobf(sr_[i].vs0);          \
    *(bf16x8*)((char*)V_lds + (b) * SHM_V + vst1) = St::tobf(sr_[i].vs1); int kc = sc * 2;               \
    *(bf16x8*)((char*)K_lds + (b) * SHM_K + KSWZ(sr, kc)) = St::tobf(sr_[i].ks0);                       \
    *(bf16x8*)((char*)K_lds + (b) * SHM_K + KSWZ(32 + sr, kc)) = St::tobf(sr_[i].ks1); } while (0)
#define SWAIT() do { if constexpr (SDEPTH == 2) asm volatile("s_waitcnt vmcnt(4)" ::: "memory"); else asm volatile("s_waitcnt vmcnt(0)" ::: "memory"); } while (0)
#define RESC(a) do { if (__any((a) < 1.f)) { if (hi == 0) al_l[r32] = (a); asm volatile("s_waitcnt lgkmcnt(0)" ::: "memory"); \
    for (int d = 0; d < 4; ++d) for (int r = 0; r < 16; ++r) o[d][r] *= al_l[crow(r, hi)]; } } while (0)
  f32x16 pA0, pA1, pB0, pB1; float mnA, mnB, alA, alB; bf16x8 pa0, pa1, pa2, pa3; const int NT = seq / KVBLK;
  constexpr int SE = 0, SO = SDEPTH - 1;
  SLOAD(SE, 0); asm volatile("s_waitcnt vmcnt(0)" ::: "memory"); SWRITE(0, SE); __syncthreads();
  qkt(pA0, pA1, K_lds, qr, r32, hi); partialSM(pA0, pA1, m_reg, mnA, alA);
  SLOAD(SO, KVBLK); if constexpr (SDEPTH == 2) { if (2 < NT) SLOAD(SE, 2 * KVBLK); }
  SWAIT(); SWRITE(1, SO); __syncthreads();
  for (int j = 1; j + 1 < NT; j += 2) {
    SBAR(); qkt(pB0, pB1, (bf16*)((char*)K_lds + SHM_K), qr, r32, hi);
    finishSM(pA0, pA1, alA, l_reg, pa0, pa1, pa2, pa3); SBAR();
    SLOAD(SO, (j + SDEPTH) * KVBLK); SBAR();
    pv_d0(o, vb0, pa0, pa1, pa2, pa3); partialSM(pB0, pB1, m_reg, mnB, alB);
    __syncthreads(); SWAIT(); SWRITE(0, SE);
    RESC(alB); __syncthreads();
    SBAR(); qkt(pA0, pA1, K_lds, qr, r32, hi);
    finishSM(pB0, pB1, alB, l_reg, pa0, pa1, pa2, pa3); SBAR();
    if (SDEPTH == 1 || j + 3 < NT) SLOAD(SE, (j + 1 + SDEPTH) * KVBLK); SBAR();
    pv_d0(o, vb0 + (int)SHM_V, pa0, pa1, pa2, pa3); partialSM(pA0, pA1, m_reg, mnA, alA);
    __syncthreads(); SWAIT(); SWRITE(1, SO);
    RESC(alA); __syncthreads();
  }
  SBAR(); qkt(pB0, pB1, (bf16*)((char*)K_lds + SHM_K), qr, r32, hi);
  finishSM(pA0, pA1, alA, l_reg, pa0, pa1, pa2, pa3); SBAR();
  pv_d0(o, vb0, pa0, pa1, pa2, pa3); partialSM(pB0, pB1, m_reg, mnB, alB);
  __syncthreads(); RESC(alB);
  finishSM(pB0, pB1, alB, l_reg, pa0, pa1, pa2, pa3); SBAR();
  pv_d0(o, vb0 + (int)SHM_V, pa0, pa1, pa2, pa3);
  if (hi == 0) li_l[r32] = l_reg; asm volatile("s_waitcnt lgkmcnt(0)" ::: "memory");
  float rli[16];
#pragma unroll
  for (int r = 0; r < 16; ++r) rli[r] = __builtin_amdgcn_rcpf(li_l[crow(r, hi)]);
  unsigned short* Ow = Ob + (long)(wid * QBLK) * LDO;
#pragma unroll
  for (int r = 0; r < 16; ++r) { int orow = crow(r, hi);
    for (int d0 = 0; d0 < 4; ++d0) Ow[(long)orow * LDO + d0 * 32 + r32] = f2bf_rne(o[d0][r] * rli[r]); }
#undef SLOAD
#undef SWRITE
#undef SWAIT
#undef RESC
}
#undef KSWZ
#undef SBAR
}

#define XB_TMO      128
#define XB_XCNT(j)  (256  + 64 * (j))
#define XB_XSUB(j)  (1280 + 64 * (j))
#define XB_XGEN(j)  (2304 + 64 * (j))
#define XB_TOP      3328
#define XB_TOPGEN   3392
#define XCD_BAR_WORDS 3456
#define XB_SPIN_CAP (1u << 18)
#define LAS __attribute__((address_space(3)))

__device__ __forceinline__ unsigned xb_ld(unsigned* p)              { return __hip_atomic_load(p, __ATOMIC_RELAXED, __HIP_MEMORY_SCOPE_AGENT); }
__device__ __forceinline__ unsigned xb_add(unsigned* p, unsigned v) { return __hip_atomic_fetch_add(p, v, __ATOMIC_RELAXED, __HIP_MEMORY_SCOPE_AGENT); }
__device__ __forceinline__ unsigned xb_xcc_id() { return (unsigned)__builtin_amdgcn_s_getreg((3 << 11) | 20) & 0xFu; }
#define XB_SPIN(cond, bar) do { unsigned _sp = 0; while (cond) { __builtin_amdgcn_s_sleep(1); \
    if ((++_sp & 255u) == 0u) { if (xb_ld(&(bar)[XB_TMO])) break; if (_sp > XB_SPIN_CAP) { atomicAdd(&(bar)[XB_TMO], 1u); break; } } } } while (0)

struct XcdBarrier {
    unsigned* bar; unsigned x; unsigned gsz;
    volatile LAS unsigned* st;
};

__device__ __forceinline__ XcdBarrier xcd_barrier_post(unsigned* bar, volatile LAS unsigned* st) {
    XcdBarrier b; b.bar = bar; b.x = xb_xcc_id(); b.st = st;
    if (threadIdx.x == 0) (void)xb_add(&bar[XB_XCNT(b.x)], 1u);
    return b;
}
__device__ __forceinline__ void xcd_barrier_complete(unsigned* bar, unsigned x, unsigned& nloc, unsigned& nx, unsigned G) {
    unsigned sum, cnt, mine, sp = 0u;
    for (;;) {
        sum = 0u; cnt = 0u; mine = 0u;
#pragma unroll
        for (unsigned j = 0; j < 16; ++j) { const unsigned c = xb_ld(&bar[XB_XCNT(j)]); sum += c; cnt += (c > 0u) ? 1u : 0u; mine = (j == x) ? c : mine; }
        if (sum == G) break;
        __builtin_amdgcn_s_sleep(1);
        if ((++sp & 255u) == 0u) { if (xb_ld(&bar[XB_TMO])) break; if (sp > XB_SPIN_CAP) { atomicAdd(&bar[XB_TMO], 1u); break; } }
    }
    nloc = mine > 0u ? mine : 1u; nx = cnt > 0u ? cnt : 1u;
}

__device__ __forceinline__ void xcd_barrier(const XcdBarrier& b) {
    asm volatile("s_waitcnt vmcnt(0)" ::: "memory");
    __syncthreads();
    if (threadIdx.x == 0) {
        unsigned* bar = b.bar;
        __builtin_amdgcn_s_waitcnt(0);
        unsigned nloc = b.st[0], nx = b.st[1];
        if (nloc == 0u) { xcd_barrier_complete(bar, b.x, nloc, nx, b.gsz); b.st[0] = nloc; b.st[1] = nx; }
        const unsigned old = xb_add(&bar[XB_XSUB(b.x)], 1u);
        const unsigned gen = old / nloc;
        if (old + 1u == (gen + 1u) * nloc) {
            __builtin_amdgcn_fence(__ATOMIC_RELEASE, "agent");
            asm volatile("s_waitcnt vmcnt(0)" ::: "memory");
            const unsigned og = xb_add(&bar[XB_TOP], 1u);
            const unsigned tg = og / nx;
            if (og + 1u == (tg + 1u) * nx) xb_add(&bar[XB_TOPGEN], 1u);
            else XB_SPIN(xb_ld(&bar[XB_TOPGEN]) == tg, bar);
            __builtin_amdgcn_fence(__ATOMIC_ACQUIRE, "agent");
            xb_add(&bar[XB_XGEN(b.x)], 1u);
            asm volatile("s_waitcnt vmcnt(0)" ::: "memory");
        } else {
            XB_SPIN(xb_ld(&bar[XB_XGEN(b.x)]) == gen, bar);
            __builtin_amdgcn_fence(__ATOMIC_ACQUIRE, "agent");
            asm volatile("s_waitcnt vmcnt(0)" ::: "memory");
        }
    }
    __syncthreads();
}

namespace mk {
using pg8::bf16_t; using pg8::bf16x8; using pg8::f32x4; using pg8::u32x4; using pg8::cvt_pk_bf16; using pg8::bf_lo; using pg8::bf_hi;
typedef unsigned u32x2 __attribute__((ext_vector_type(2)));
constexpr int T = 32768, DM = 1024, FF = 2816, SEQ = 2048, NZ1 = 4096, NZ2 = 3584, NWIN = 6688;
constexpr float EPS = 1e-6f;
constexpr size_t MiB = (size_t)1 << 20, HMiB = (size_t)1 << 19;
constexpr size_t WS_W1IN = 0, WS_W1OUT = 11 * MiB, WS_WIN = 16 * MiB + HMiB, WS_WA = 31 * MiB + HMiB, WS_WB = 33 * MiB + HMiB, WS_WO = 35 * MiB + HMiB,
                 WS_W2IN = 37 * MiB + HMiB, WS_W2OUT = 48 * MiB + HMiB, WS_XN = 56 * MiB, WS_F = 120 * MiB, WS_Z = 184 * MiB, WS_OG = 440 * MiB, WS_CTL = 504 * MiB, WS_RN = 504 * MiB + 65536, WS_END = 504 * MiB + 65536 + 131072;
constexpr int LDS_BYTES = 149504 + 16;
#define LBAR() do { asm volatile("s_waitcnt lgkmcnt(0)" ::: "memory"); __builtin_amdgcn_s_barrier(); asm volatile("" ::: "memory"); } while (0)

__device__ __forceinline__ float wave_sum(float v) {
#pragma unroll
    for (int o = 32; o > 0; o >>= 1) v += __shfl_xor(v, o);
    return v;
}

enum { CM_ID = 0, CM_SWIGLU = 1, CM_WIN_A = 2, CM_WIN_B = 3, CM_FOLD = 4 };
__device__ __forceinline__ void cvt_job(int& tbase, const float* __restrict__ src, int Nsrc, int K, bf16_t* __restrict__ dst, int ndst, int mode,
                                        const float* __restrict__ gain, const float* __restrict__ up_f, const float* __restrict__ up_b, int bi, int nb) {
    const int lane = threadIdx.x & 63, gw = bi * 8 + (threadIdx.x >> 6), nw = nb * 8;
    const int nT = ndst >> 6, kT = K >> 6, ntile = nT * kT;
    int t0 = (gw - tbase % nw + nw) % nw; tbase += ntile;
    for (int t = t0; t < ntile; t += nw) {
        const int n0 = (t % nT) << 6, k0 = (t / nT) << 6, n = n0 + lane;
        int col = n; float scale = 1.f;
        if (mode == CM_SWIGLU) { const int j = n & 255, pn = n >> 8; col = (j < 128) ? pn * 128 + j : FF + pn * 128 + (j - 128); }
        else if (mode == CM_WIN_A) { scale = (n < 512) ? 0.08838834764831845f : 1.f; }
        else if (mode == CM_WIN_B) { col = 3104 + n; }
        float v[64];
        if (mode == CM_FOLD) {
            const int dirb = n >> 9, c = n & 511; const float* up = dirb ? up_b : up_f;
            float upv[16];
#pragma unroll
            for (int r = 0; r < 16; ++r) upv[r] = up[r * 512 + c];
#pragma unroll
            for (int j = 0; j < 64; ++j) { const float* wp = src + (size_t)(k0 + j) * Nsrc + 3072 + 16 * dirb; float sacc = 0.f;
#pragma unroll
                for (int r = 0; r < 16; ++r) sacc += wp[r] * upv[r];
                v[j] = sacc; }
        } else {
            const float* sp = src + (size_t)k0 * Nsrc + col;
#pragma unroll
            for (int j = 0; j < 64; ++j) v[j] = sp[(size_t)j * Nsrc];
        }
        bf16_t* dp = dst + (size_t)n * K + k0;
        if (gain) {
#pragma unroll
            for (int j8 = 0; j8 < 8; ++j8) { const f32x4 g0 = *(const f32x4*)(gain + k0 + 8 * j8), g1 = *(const f32x4*)(gain + k0 + 8 * j8 + 4);
                u32x4 w; w.x = cvt_pk_bf16(v[8 * j8] * g0[0] * scale, v[8 * j8 + 1] * g0[1] * scale); w.y = cvt_pk_bf16(v[8 * j8 + 2] * g0[2] * scale, v[8 * j8 + 3] * g0[3] * scale);
                w.z = cvt_pk_bf16(v[8 * j8 + 4] * g1[0] * scale, v[8 * j8 + 5] * g1[1] * scale); w.w = cvt_pk_bf16(v[8 * j8 + 6] * g1[2] * scale, v[8 * j8 + 7] * g1[3] * scale);
                *(u32x4*)(dp + 8 * j8) = w; }
        } else {
#pragma unroll
            for (int j8 = 0; j8 < 8; ++j8) { u32x4 w; w.x = cvt_pk_bf16(v[8 * j8], v[8 * j8 + 1]); w.y = cvt_pk_bf16(v[8 * j8 + 2], v[8 * j8 + 3]);
                w.z = cvt_pk_bf16(v[8 * j8 + 4], v[8 * j8 + 5]); w.w = cvt_pk_bf16(v[8 * j8 + 6], v[8 * j8 + 7]); *(u32x4*)(dp + 8 * j8) = w; }
        }
    }
}
__device__ __forceinline__ float sq4(const f32x4 v) { return v[0] * v[0] + v[1] * v[1] + v[2] * v[2] + v[3] * v[3]; }
__device__ __forceinline__ void rows_prenorm(const float* __restrict__ x, bf16_t* __restrict__ XN, float* __restrict__ RN, int bi, int nb, int nrows) {
    const int lane = threadIdx.x & 63, gw = bi * 8 + (threadIdx.x >> 6), nw = nb * 8;
    for (int row = gw; row < nrows; row += 2 * nw) {
        f32x4 v[2][4]; float ss[2] = {0.f, 0.f};
#pragma unroll
        for (int u = 0; u < 2; ++u) { const float* xp = x + (size_t)(row + u * nw) * DM + 4 * lane;
#pragma unroll
            for (int c = 0; c < 4; ++c) v[u][c] = *(const f32x4*)(xp + 256 * c); }
#pragma unroll
        for (int u = 0; u < 2; ++u) {
#pragma unroll
            for (int c = 0; c < 4; ++c) ss[u] += sq4(v[u][c]);
            ss[u] = wave_sum(ss[u]); const float ms = ss[u] * (1.0f / DM) + EPS, ri = rsqrtf(ms);
            if (lane == 0) RN[row + u * nw] = ms * ri;
            bf16_t* op = XN + (size_t)(row + u * nw) * DM + 4 * lane;
#pragma unroll
            for (int c = 0; c < 4; ++c) { u32x2 w; w.x = cvt_pk_bf16(v[u][c][0] * ri, v[u][c][1] * ri); w.y = cvt_pk_bf16(v[u][c][2] * ri, v[u][c][3] * ri); *(u32x2*)(op + 256 * c) = w; } }
    }
}
template <int BASE_BF16  , bool OUT_BF16>
__device__ __forceinline__ void rows_resnorm(const bf16_t* __restrict__ F, const void* base, const float* __restrict__ gain, float coef, void* __restrict__ out, bf16_t* XN, const float* __restrict__ rn, int bi, int nb, int nrows) {
    const int lane = threadIdx.x & 63, gw = bi * 8 + (threadIdx.x >> 6), nw = nb * 8;
    f32x4 g[4];
#pragma unroll
    for (int c = 0; c < 4; ++c) g[c] = *(const f32x4*)(gain + 256 * c + 4 * lane);
    for (int row = gw; row < nrows; row += 2 * nw) {
        f32x4 f[2][4], h[2][4];
#pragma unroll
        for (int u = 0; u < 2; ++u) { const size_t ro = (size_t)(row + u * nw) * DM + 4 * lane;
#pragma unroll
            for (int c = 0; c < 4; ++c) { const u32x2 w = __builtin_nontemporal_load((const u32x2*)(F + ro + 256 * c)); f[u][c] = (f32x4){bf_lo(w.x), bf_hi(w.x), bf_lo(w.y), bf_hi(w.y)};
                if (BASE_BF16) { const u32x2 bw = __builtin_nontemporal_load((const u32x2*)((const bf16_t*)base + ro + 256 * c)); h[u][c] = (f32x4){bf_lo(bw.x), bf_hi(bw.x), bf_lo(bw.y), bf_hi(bw.y)}; if (BASE_BF16 == 2) h[u][c] = h[u][c] * rn[row + u * nw]; }
                else h[u][c] = __builtin_nontemporal_load((const f32x4*)((const float*)base + ro + 256 * c)); } }
#pragma unroll
        for (int u = 0; u < 2; ++u) { const size_t ro = (size_t)(row + u * nw) * DM + 4 * lane; float ss = 0.f;
#pragma unroll
            for (int c = 0; c < 4; ++c) ss += sq4(f[u][c]);
            ss = wave_sum(ss); const float ri = rsqrtf(ss * (1.0f / DM) + EPS) * coef; float s2 = 0.f;
#pragma unroll
            for (int c = 0; c < 4; ++c) { h[u][c] += f[u][c] * g[c] * ri; s2 += sq4(h[u][c]);
                if (OUT_BF16) { u32x2 w; w.x = cvt_pk_bf16(h[u][c][0], h[u][c][1]); w.y = cvt_pk_bf16(h[u][c][2], h[u][c][3]); __builtin_nontemporal_store(w, (u32x2*)((bf16_t*)out + ro + 256 * c)); }
                else __builtin_nontemporal_store(h[u][c], (f32x4*)((float*)out + ro + 256 * c)); }
            if (XN) { s2 = wave_sum(s2); const float r2 = rsqrtf(s2 * (1.0f / DM) + EPS);
#pragma unroll
                for (int c = 0; c < 4; ++c) { u32x2 w; w.x = cvt_pk_bf16(h[u][c][0] * r2, h[u][c][1] * r2); w.y = cvt_pk_bf16(h[u][c][2] * r2, h[u][c][3] * r2); *(u32x2*)(XN + ro + 256 * c) = w; } } }
    }
}
__device__ __forceinline__ void rows_gla_merge(bf16_t* OF, const bf16_t* __restrict__ OB, const bf16_t* __restrict__ Z1, const float* __restrict__ og, int bi, int nb, int nrows) {
    const int lane = threadIdx.x & 63, gw = bi * 8 + (threadIdx.x >> 6), nw = nb * 8;
    f32x4 g[4];
#pragma unroll
    for (int c = 0; c < 4; ++c) g[c] = *(const f32x4*)(og + 256 * c + 4 * lane);
    for (int row = gw; row < nrows; row += 2 * nw) {
        u32x2 ra[2][4], rb[2][4], rr_[2][4];
#pragma unroll
        for (int u = 0; u < 2; ++u) { const size_t ro = (size_t)(row + u * nw) * DM + 4 * lane; const bf16_t* zr = Z1 + (size_t)(row + u * nw) * NZ1 + 2048 + 4 * lane;
#pragma unroll
            for (int c = 0; c < 4; ++c) { ra[u][c] = __builtin_nontemporal_load((const u32x2*)(OF + ro + 256 * c)); rb[u][c] = __builtin_nontemporal_load((const u32x2*)(OB + ro + 256 * c)); rr_[u][c] = __builtin_nontemporal_load((const u32x2*)(zr + 256 * c)); } }
#pragma unroll
        for (int u = 0; u < 2; ++u) { const size_t ro = (size_t)(row + u * nw) * DM + 4 * lane;
#pragma unroll
            for (int c = 0; c < 4; ++c) { const u32x2 a = ra[u][c], b = rb[u][c], r = rr_[u][c];
                f32x4 o = (f32x4){bf_lo(a.x) + bf_lo(b.x), bf_hi(a.x) + bf_hi(b.x), bf_lo(a.y) + bf_lo(b.y), bf_hi(a.y) + bf_hi(b.y)};
                float ss = wave_sum(o[0] * o[0] + o[1] * o[1] + o[2] * o[2] + o[3] * o[3]); const float ri = rsqrtf(ss * (1.0f / 256.0f) + EPS);
                const f32x4 rr = (f32x4){bf_lo(r.x), bf_hi(r.x), bf_lo(r.y), bf_hi(r.y)}; o = o * g[c] * rr * ri;
                u32x2 w; w.x = cvt_pk_bf16(o[0], o[1]); w.y = cvt_pk_bf16(o[2], o[3]); *(u32x2*)(OF + ro + 256 * c) = w; } }
    }
}
__device__ __forceinline__ void rows_rope(bf16_t* Z2, const float* __restrict__ qg, const float* __restrict__ kg, int bi, int nb, int nrows) {
    const int lane = threadIdx.x & 63, gw = bi * 8 + (threadIdx.x >> 6), nw = nb * 8;
    const int e0 = 2 * lane, jf = e0 & 31;
    const float if0 = exp2f(-(float)jf * (13.287712379549449f / 32.0f)), if1 = exp2f(-(float)(jf + 1) * (13.287712379549449f / 32.0f));
    const float gq0 = qg[e0], gq1 = qg[e0 + 1], gk0 = kg[e0], gk1 = kg[e0 + 1];
    const bool second = (e0 & 32) != 0;
    for (int tok = gw; tok < nrows; tok += 4 * nw) {
        unsigned xr[4][10];
#pragma unroll
        for (int u = 0; u < 4; ++u) { const unsigned* bp = (const unsigned*)(Z2 + (size_t)(tok + u * nw) * NZ2) + lane;
#pragma unroll
            for (int hh = 8; hh < 10; ++hh) xr[u][hh] = bp[hh * 64]; }
#pragma unroll
        for (int u = 0; u < 4; ++u) { const int t = tok + u * nw, pos = t & (SEQ - 1);
            const float p = (float)((lane < 32) ? (pos >> 6) : (pos & 63));
            float s0, c0, s1, c1; sincosf(p * if0, &s0, &c0); sincosf(p * if1, &s1, &c1);
            if (!second) { s0 = -s0; s1 = -s1; }
            unsigned* op = (unsigned*)(Z2 + (size_t)t * NZ2) + lane;
#pragma unroll
            for (int hh = 8; hh < 10; ++hh) { const float x0 = bf_lo(xr[u][hh]), x1 = bf_hi(xr[u][hh]);
                const float ss = wave_sum(x0 * x0 + x1 * x1), ri = rsqrtf(ss * (1.0f / 128.0f) + EPS);
                const float y0 = x0 * ri * (hh < 8 ? gq0 : gk0), y1 = x1 * ri * (hh < 8 ? gq1 : gk1);
                const float z0 = __shfl_xor(y0, 16), z1 = __shfl_xor(y1, 16);
                op[hh * 64] = cvt_pk_bf16(y0 * c0 + z0 * s0, y1 * c1 + z1 * s1); }
        }
    }
}
__device__ __forceinline__ void gla_phase(unsigned char* lds, const bf16_t* __restrict__ Z1, bf16_t* __restrict__ Of, bf16_t* __restrict__ Ob, int bi, int nb, int nitems) {
    int tid_ = threadIdx.x; asm volatile("" : "+v"(tid_));
    const int tid = tid_, lane = tid & 63, w = tid >> 6, r = lane & 15, q = lane >> 4;
    constexpr int QS_B = 64 * 136 * 2, KD_B = 128 * 72 * 2, VT_B = 128 * 72 * 2, PP_B = 64 * 72 * 2, DEC_B = 512, BUF_B = QS_B + KD_B + VT_B + PP_B + DEC_B;
    bf16_t* KS = (bf16_t*)(lds + 2 * BUF_B);
    float* SEG = (float*)(lds + 2 * BUF_B + QS_B);
    const int d2 = lane * 2;
#define GLA_WAIT() do { asm volatile("s_waitcnt lgkmcnt(0)" ::: "memory"); __builtin_amdgcn_sched_barrier(0); } while (0)
    for (int it0 = bi; it0 < nitems; it0 += nb) {
        const int item = (nitems == 128 && nb == 128) ? ((it0 & 7) * 16 + (it0 >> 3)) : it0;
        const int dir = item & 1, dvs = (item >> 1) & 1, h = (item >> 2) & 3, b = item >> 4;
        const bf16_t* zq = Z1 + (size_t)(b * SEQ + 8 * w) * NZ1 + h * 128 + d2;
        const bf16_t* zk = zq + 512;
        const bf16_t* zv = Z1 + (size_t)(b * SEQ + 8 * w) * NZ1 + 1024 + h * 256 + dvs * 128 + d2;
        const bf16_t* zg = zq + 3072 + dir * 512;
        bf16_t* og = (dir ? Ob : Of) + (size_t)(b * SEQ) * DM + h * 256 + dvs * 128 + 16 * w + r;
        f32x4 S[8];
#pragma unroll
        for (int mb = 0; mb < 8; ++mb) S[mb] = (f32x4){0.f, 0.f, 0.f, 0.f};
        unsigned rq[8], rk[8], rg[8], rv[8];
        { const size_t co = (size_t)((dir ? 31 : 0) * 64) * NZ1;
#pragma unroll
          for (int tt = 0; tt < 8; ++tt) { const size_t o = co + (size_t)tt * NZ1; rq[tt] = *(const unsigned*)(zq + o); rk[tt] = *(const unsigned*)(zk + o); rg[tt] = *(const unsigned*)(zg + o); rv[tt] = *(const unsigned*)(zv + o); } }
        float ga[8], gb[8];
        for (int step = -1; step < 32; ++step) {
            const int c = dir ? 31 - step : step;
            const int cnn = dir ? c - 2 : c + 2;
            const bool prod = step + 1 < 32, cons = step >= 0, pref = step + 2 < 32;
            unsigned char* bx = lds + (step & 1) * BUF_B;
            unsigned char* by = lds + ((step + 1) & 1) * BUF_B;
            bf16_t* QSx = (bf16_t*)bx; bf16_t* KDx = (bf16_t*)(bx + QS_B); bf16_t* VTx = (bf16_t*)(bx + QS_B + KD_B); bf16_t* PPx = (bf16_t*)(bx + QS_B + KD_B + VT_B); float* DECx = (float*)(bx + QS_B + KD_B + VT_B + PP_B);
            bf16_t* QSy = (bf16_t*)by; bf16_t* KDy = (bf16_t*)(by + QS_B); bf16_t* VTy = (bf16_t*)(by + QS_B + KD_B); bf16_t* PPy = (bf16_t*)(by + QS_B + KD_B + VT_B); float* DECy = (float*)(by + QS_B + KD_B + VT_B + PP_B);
            f32x4 O[4];
            O[0] = (f32x4){0.f, 0.f, 0.f, 0.f}; O[1] = O[0]; O[2] = O[0]; O[3] = O[0];
            if (cons) {
                bf16x8 sbf[4];
#pragma unroll
                for (int kk = 0; kk < 4; ++kk) { u32x4 t; t.x = cvt_pk_bf16(S[2 * kk][0], S[2 * kk][1]); t.y = cvt_pk_bf16(S[2 * kk][2], S[2 * kk][3]); t.z = cvt_pk_bf16(S[2 * kk + 1][0], S[2 * kk + 1][1]); t.w = cvt_pk_bf16(S[2 * kk + 1][2], S[2 * kk + 1][3]); sbf[kk] = *reinterpret_cast<bf16x8*>(&t); }
#pragma unroll
                for (int tp = 0; tp < 2; ++tp) { u32x4 af[2][4];
#pragma unroll
                    for (int t2 = 0; t2 < 2; ++t2)
#pragma unroll
                        for (int kk = 0; kk < 4; ++kk) { const bf16_t* ap = QSx + (16 * (2 * tp + t2) + r) * 136 + 32 * kk + 4 * q; const u32x2 lo = *(const u32x2*)ap, hi = *(const u32x2*)(ap + 16); af[t2][kk] = (u32x4){lo.x, lo.y, hi.x, hi.y}; }
                    GLA_WAIT();
#pragma unroll
                    for (int t2 = 0; t2 < 2; ++t2)
#pragma unroll
                        for (int kk = 0; kk < 4; ++kk) O[2 * tp + t2] = __builtin_amdgcn_mfma_f32_16x16x32_bf16(*reinterpret_cast<bf16x8*>(&af[t2][kk]), sbf[kk], O[2 * tp + t2], 0, 0, 0);
                    __builtin_amdgcn_sched_barrier(0); }
            }
            if (prod) {
#pragma unroll
                for (int tt = 0; tt < 8; ++tt) { ga[tt] = bf_lo(rg[tt]); gb[tt] = bf_hi(rg[tt]); }
                if (!dir) {
#pragma unroll
                    for (int tt = 1; tt < 8; ++tt) { ga[tt] += ga[tt - 1]; gb[tt] += gb[tt - 1]; }
                    *(float2*)(SEG + w * 128 + d2) = make_float2(ga[7], gb[7]);
                } else {
#pragma unroll
                    for (int tt = 6; tt >= 0; --tt) { ga[tt] += ga[tt + 1]; gb[tt] += gb[tt + 1]; }
                    *(float2*)(SEG + w * 128 + d2) = make_float2(ga[0], gb[0]);
                }
                { u32x4 va, vb;
                  va.x = (rv[0] & 0xffffu) | (rv[1] << 16); va.y = (rv[2] & 0xffffu) | (rv[3] << 16); va.z = (rv[4] & 0xffffu) | (rv[5] << 16); va.w = (rv[6] & 0xffffu) | (rv[7] << 16);
                  vb.x = (rv[0] >> 16) | (rv[1] & 0xffff0000u); vb.y = (rv[2] >> 16) | (rv[3] & 0xffff0000u); vb.z = (rv[4] >> 16) | (rv[5] & 0xffff0000u); vb.w = (rv[6] >> 16) | (rv[7] & 0xffff0000u);
                  *(u32x4*)(VTy + d2 * 72 + 8 * w) = va; *(u32x4*)(VTy + (d2 + 1) * 72 + 8 * w) = vb; }
                if (pref) { const size_t co = (size_t)(cnn * 64) * NZ1;
#pragma unroll
                    for (int tt = 0; tt < 8; ++tt) { const size_t o = co + (size_t)tt * NZ1; rg[tt] = *(const unsigned*)(zg + o); rv[tt] = *(const unsigned*)(zv + o); } }
            }
            LBAR();
            if (cons) {
                const bf16x8 v0 = *(const bf16x8*)(VTx + (16 * w + r) * 72 + 8 * q), v1 = *(const bf16x8*)(VTx + (16 * w + r) * 72 + 32 + 8 * q);
#pragma unroll
                for (int hb = 0; hb < 2; ++hb) { bf16x8 kd0[4], kd1[4]; f32x4 dc[4];
#pragma unroll
                    for (int m4 = 0; m4 < 4; ++m4) { const int mb = 4 * hb + m4; dc[m4] = *(const f32x4*)(DECx + 16 * mb + 4 * q);
                        kd0[m4] = *(const bf16x8*)(KDx + (16 * mb + r) * 72 + 8 * q); kd1[m4] = *(const bf16x8*)(KDx + (16 * mb + r) * 72 + 32 + 8 * q); }
                    GLA_WAIT();
#pragma unroll
                    for (int m4 = 0; m4 < 4; ++m4) { const int mb = 4 * hb + m4; S[mb] = S[mb] * dc[m4];
                        S[mb] = __builtin_amdgcn_mfma_f32_16x16x32_bf16(kd0[m4], v0, S[mb], 0, 0, 0); S[mb] = __builtin_amdgcn_mfma_f32_16x16x32_bf16(kd1[m4], v1, S[mb], 0, 0, 0); }
                    __builtin_amdgcn_sched_barrier(0); }
            }
            if (prod) {
                float offa = 0.f, offb = 0.f, tota = 0.f, totb = 0.f;
#pragma unroll
                for (int s = 0; s < 8; ++s) { const float2 v = *(const float2*)(SEG + s * 128 + d2); tota += v.x; totb += v.y; const bool inc = dir ? (s > w) : (s < w); offa += inc ? v.x : 0.f; offb += inc ? v.y : 0.f; }
                const float eta = __expf(tota), etb = __expf(totb);
                if (w == 0) *(float2*)(DECy + d2) = make_float2(eta, etb);
                float kda[8], kdb[8];
#pragma unroll
                for (int tt = 0; tt < 8; ++tt) { const float ba = offa + ga[tt], bb = offb + gb[tt];
                    const float ea = __expf(ba), eb = __expf(bb), iea = __expf(-ba), ieb = __expf(-bb);
                    const float ksa = bf_lo(rk[tt]) * iea, ksb = bf_hi(rk[tt]) * ieb;
                    *(unsigned*)(QSy + (8 * w + tt) * 136 + d2) = cvt_pk_bf16(bf_lo(rq[tt]) * ea, bf_hi(rq[tt]) * eb);
                    *(unsigned*)(KS + (8 * w + tt) * 136 + d2) = cvt_pk_bf16(ksa, ksb);
                    kda[tt] = ksa * eta; kdb[tt] = ksb * etb; }
                u32x4 ka, kb;
                ka.x = cvt_pk_bf16(kda[0], kda[1]); ka.y = cvt_pk_bf16(kda[2], kda[3]); ka.z = cvt_pk_bf16(kda[4], kda[5]); ka.w = cvt_pk_bf16(kda[6], kda[7]);
                kb.x = cvt_pk_bf16(kdb[0], kdb[1]); kb.y = cvt_pk_bf16(kdb[2], kdb[3]); kb.z = cvt_pk_bf16(kdb[4], kdb[5]); kb.w = cvt_pk_bf16(kdb[6], kdb[7]);
                *(u32x4*)(KDy + d2 * 72 + 8 * w) = ka; *(u32x4*)(KDy + (d2 + 1) * 72 + 8 * w) = kb;
                if (pref) { const size_t co = (size_t)(cnn * 64) * NZ1;
#pragma unroll
                    for (int tt = 0; tt < 8; ++tt) { const size_t o = co + (size_t)tt * NZ1; rq[tt] = *(const unsigned*)(zq + o); rk[tt] = *(const unsigned*)(zk + o); } }
            }
            LBAR();
            if (cons) {
                bf16x8 pp0[4], pp1[4];
                const bf16x8 v0 = *(const bf16x8*)(VTx + (16 * w + r) * 72 + 8 * q), v1 = *(const bf16x8*)(VTx + (16 * w + r) * 72 + 32 + 8 * q);
#pragma unroll
                for (int tb = 0; tb < 4; ++tb) { pp0[tb] = *(const bf16x8*)(PPx + (16 * tb + r) * 72 + 8 * q); pp1[tb] = *(const bf16x8*)(PPx + (16 * tb + r) * 72 + 32 + 8 * q); }
                GLA_WAIT();
#pragma unroll
                for (int tb = 0; tb < 4; ++tb) { O[tb] = __builtin_amdgcn_mfma_f32_16x16x32_bf16(pp0[tb], v0, O[tb], 0, 0, 0); O[tb] = __builtin_amdgcn_mfma_f32_16x16x32_bf16(pp1[tb], v1, O[tb], 0, 0, 0); }
                bf16_t* op = og + (size_t)(c * 64) * DM;
#pragma unroll
                for (int tb = 0; tb < 4; ++tb)
#pragma unroll
                    for (int i = 0; i < 4; ++i) op[(size_t)(16 * tb + 4 * q + i) * DM] = attn::f2bf_rne(O[tb][i]);
            }
            if (prod) {
                const int tb = w >> 1; f32x4 p0 = (f32x4){0.f, 0.f, 0.f, 0.f}, p1 = p0;
                bf16x8 pa[4], pb0[4], pb1[4];
#pragma unroll
                for (int kk = 0; kk < 4; ++kk) { pa[kk] = *(const bf16x8*)(QSy + (16 * tb + r) * 136 + 32 * kk + 8 * q);
                    pb0[kk] = *(const bf16x8*)(KS + (32 * (w & 1) + r) * 136 + 32 * kk + 8 * q); pb1[kk] = *(const bf16x8*)(KS + (32 * (w & 1) + 16 + r) * 136 + 32 * kk + 8 * q); }
                GLA_WAIT();
#pragma unroll
                for (int kk = 0; kk < 4; ++kk) { p0 = __builtin_amdgcn_mfma_f32_16x16x32_bf16(pa[kk], pb0[kk], p0, 0, 0, 0); p1 = __builtin_amdgcn_mfma_f32_16x16x32_bf16(pa[kk], pb1[kk], p1, 0, 0, 0); }
                const int j0 = 32 * (w & 1) + r, j1 = j0 + 16;
#pragma unroll
                for (int i = 0; i < 4; ++i) { const int it = 16 * tb + 4 * q + i;
                    const bool k0 = dir ? (j0 > it) : (j0 <= it), k1 = dir ? (j1 > it) : (j1 <= it);
                    PPy[it * 72 + j0] = attn::f2bf_rne(k0 ? p0[i] : 0.f); PPy[it * 72 + j1] = attn::f2bf_rne(k1 ? p1[i] : 0.f); }
            }
            LBAR();
        }
    }
#undef GLA_WAIT
}

__device__ __forceinline__ void attn_phase(unsigned char* lds, const bf16_t* Z2, bf16_t* OA, const float* __restrict__ qg, int bi, int nb, int nunits) {
    for (int u0 = bi, i_ = 0; u0 < nunits; u0 += nb, ++i_) {
        int u = u0;
        if (nunits == 512 && nb == 128) { const int x = bi & 7, t = i_ * 16 + (bi >> 3), bk = x * 2 + (t >> 5);
            u = ((bk >> 1) << 6) | ((((bk & 1) << 2) | ((t >> 3) & 3)) << 3) | (t & 7); }
        const int qb = u & 7, hq = (u >> 3) & 7, b = u >> 6, kvh = hq >> 2;
        const size_t row0 = (size_t)b * SEQ;
        const attn::bf16* Qb = (const attn::bf16*)(Z2 + (row0 + qb * 256) * NZ2 + hq * 128);
        const attn::bf16* Kh = (const attn::bf16*)(Z2 + row0 * NZ2 + 1024 + kvh * 128);
        const attn::bf16* Vh = (const attn::bf16*)(Z2 + row0 * NZ2 + 1280 + kvh * 128);
        attn::attn_dense_body<attn::bf16>(Qb, Kh, Vh, OA + (row0 + qb * 256) * DM + hq * 128, SEQ, (char*)lds, qg, qb * 256);
        __syncthreads();
    }
}

constexpr int NPHASE = 17;
struct Args { const float* in[22]; float* out; unsigned char* ws; int ph_lo, ph_hi; };

__global__ void __launch_bounds__(512, 2) mk_fwd(Args a) {
    extern __shared__ __attribute__((aligned(16))) unsigned char lds[];
    cg::grid_group grid = cg::this_grid();
    PG8_LAS unsigned char* llds = (PG8_LAS unsigned char*)lds;
    unsigned char* ws = a.ws;
    bf16_t* W1IN = (bf16_t*)(ws + WS_W1IN); bf16_t* W1OUT = (bf16_t*)(ws + WS_W1OUT); bf16_t* WIN = (bf16_t*)(ws + WS_WIN);
    bf16_t* WA = (bf16_t*)(ws + WS_WA); bf16_t* WB = (bf16_t*)(ws + WS_WB); bf16_t* WO = (bf16_t*)(ws + WS_WO);
    bf16_t* W2IN = (bf16_t*)(ws + WS_W2IN); bf16_t* W2OUT = (bf16_t*)(ws + WS_W2OUT);
    const int G = gridDim.x, bx = blockIdx.x, GG = G >> 1;
    constexpr int TG = T / 2;
#define GV() int bxo_ = blockIdx.x; asm volatile("" : "+s"(bxo_)); const int grp = (bxo_ >> 3) & 1, gi = (bxo_ & 7) | ((bxo_ >> 4) << 3); const size_t R0 = (size_t)grp * TG; \
    bf16_t* XN = (bf16_t*)(ws + WS_XN) + R0 * DM; bf16_t* FB = (bf16_t*)(ws + WS_F) + R0 * DM; bf16_t* OG = (bf16_t*)(ws + WS_OG) + R0 * DM; \
    bf16_t* ZB = (bf16_t*)(ws + WS_Z + (size_t)grp * (128 * MiB)); bf16_t* HP = (bf16_t*)(a.out + R0 * DM); float* OUTF = a.out + R0 * DM; float* RN = (float*)(ws + WS_RN) + R0; \
    (void)gi; (void)XN; (void)FB; (void)OG; (void)ZB; (void)HP; (void)OUTF; (void)RN
    volatile LAS unsigned* xst = (volatile LAS unsigned*)(llds + (LDS_BYTES - 16));
    if (threadIdx.x < 4) xst[threadIdx.x] = 0u;
    __syncthreads();
    { GV(); (void)xcd_barrier_post((unsigned*)(ws + WS_CTL), xst); (void)xcd_barrier_post((unsigned*)(ws + WS_CTL) + (1 + grp) * 4096, xst + 2); }
    if (a.ph_lo < 0) grid.sync();
#define BAR_ALL() do { XcdBarrier xb_; xb_.bar = (unsigned*)(ws + WS_CTL); xb_.x = xb_xcc_id(); xb_.gsz = (unsigned)G; xb_.st = xst; xcd_barrier(xb_); } while (0)
#define SEAM() do { XcdBarrier xb_; xb_.bar = (unsigned*)(ws + WS_CTL) + (1 + ((blockIdx.x >> 3) & 1)) * 4096; xb_.x = xb_xcc_id(); xb_.gsz = (unsigned)GG; xb_.st = xst + 2; xcd_barrier(xb_); } while (0)
    using namespace pg8;
    { int tl = 0;
      cvt_job(tl, a.in[2], 2 * FF, DM, W1IN, 2 * FF, CM_SWIGLU, a.in[1], nullptr, nullptr, bx, G);
      rows_prenorm(a.in[0], (bf16_t*)(ws + WS_XN), (float*)(ws + WS_RN), bx, G, T); }
    BAR_ALL();
    if (((blockIdx.x >> 3) & 1) == 1) { GV(); int tl = 0;
      cvt_job(tl, a.in[3], DM, FF, W1OUT, DM, CM_ID, nullptr, nullptr, nullptr, gi, GG);
      cvt_job(tl, a.in[6], NWIN, DM, WIN, 3072, CM_WIN_A, a.in[5], nullptr, nullptr, gi, GG);
      cvt_job(tl, a.in[6], NWIN, DM, WIN + (size_t)3072 * DM, 1024, CM_FOLD, a.in[5], a.in[7], a.in[9], gi, GG);
      cvt_job(tl, a.in[6], NWIN, DM, WIN + (size_t)4096 * DM, NZ2, CM_WIN_B, a.in[5], nullptr, nullptr, gi, GG);
      cvt_job(tl, a.in[12], DM, DM, WA, DM, CM_ID, nullptr, nullptr, nullptr, gi, GG);
      cvt_job(tl, a.in[15], DM, DM, WB, DM, CM_ID, nullptr, nullptr, nullptr, gi, GG);
      cvt_job(tl, a.in[16], DM, DM, WO, DM, CM_ID, nullptr, nullptr, nullptr, gi, GG);
      cvt_job(tl, a.in[19], 2 * FF, DM, W2IN, 2 * FF, CM_SWIGLU, a.in[18], nullptr, nullptr, gi, GG);
      cvt_job(tl, a.in[20], DM, FF, W2OUT, DM, CM_ID, nullptr, nullptr, nullptr, gi, GG);
      SEAM();
      if (threadIdx.x == 0) __hip_atomic_fetch_add((unsigned*)(ws + WS_CTL) + 3 * 4096, 1u, __ATOMIC_RELAXED, __HIP_MEMORY_SCOPE_AGENT);
    }
    { GV(); Gemm g{XN, W1IN, TG, 2 * FF, DM}; StaticOrder S; S.init(TG, 2 * FF, GG, gi); EpiSwiglu E{ZB, FF}; gemm_phase<EpiSwiglu, StaticOrder>(llds, g, S, E); }
    SEAM();
    if (((blockIdx.x >> 3) & 1) == 0) {
        if (threadIdx.x == 0) { unsigned sp = 0; while (__hip_atomic_load((unsigned*)(ws + WS_CTL) + 3 * 4096, __ATOMIC_RELAXED, __HIP_MEMORY_SCOPE_AGENT) < (unsigned)GG && ++sp < (1u << 22)) __builtin_amdgcn_s_sleep(2);
            __builtin_amdgcn_fence(__ATOMIC_ACQUIRE, "agent"); asm volatile("s_waitcnt vmcnt(0)" ::: "memory"); }
        __syncthreads();
    }
    { GV(); Gemm g{ZB, W1OUT, TG, DM, FF}; StaticOrder S; S.init(TG, DM, GG, gi); EpiAct E{FB, DM, 0, nullptr, nullptr}; gemm_phase<EpiAct, StaticOrder>(llds, g, S, E); }
    SEAM();
    { GV(); rows_resnorm<2, true>(FB, XN, a.in[4], 0.5f, HP, XN, RN, gi, GG, TG); }
    SEAM();
    { GV(); Gemm g{XN, WIN, TG, NZ1, DM}; StaticOrder S; S.init(TG, NZ1, GG, gi); EpiAct E{ZB, NZ1, 1, a.in[8], a.in[10]}; gemm_phase<EpiAct, StaticOrder>(llds, g, S, E); }
    SEAM();
    { GV(); gla_phase(lds, ZB, OG, FB, gi, GG, 128); }
    SEAM();
    { GV(); rows_gla_merge(OG, FB, ZB, a.in[11], gi, GG, TG); }
    SEAM();
    { GV(); Gemm g{XN, WIN + (size_t)4096 * DM, TG, NZ2, DM}; StaticOrder S; S.init(TG, NZ2, GG, gi); EpiAct E{ZB, NZ2, 2, nullptr, nullptr}; gemm_phase<EpiAct, StaticOrder>(llds, g, S, E); }
    SEAM();
    { GV(); rows_rope(ZB, a.in[13], a.in[14], gi, GG, TG); }
    SEAM();
    { GV(); attn_phase(lds, ZB, XN, a.in[13], gi, GG, 512); }
    SEAM();
    { GV(); Gemm g{OG, WA, TG, DM, DM}; StaticOrder S; S.init(TG, DM, GG, gi); EpiGate<false> E{FB, DM, ZB + 1536, NZ2}; gemm_phase<EpiGate<false>, StaticOrder>(llds, g, S, E); }
    { GV(); Gemm g{XN, WB, TG, DM, DM}; StaticOrder S; S.init(TG, DM, GG, gi); EpiGate<true> E{FB, DM, ZB + 2560, NZ2}; gemm_phase<EpiGate<true>, StaticOrder>(llds, g, S, E); }
    SEAM();
    { GV(); Gemm g{FB, WO, TG, DM, DM}; StaticOrder S; S.init(TG, DM, GG, gi); EpiAct E{ZB, DM, 0, nullptr, nullptr}; gemm_phase<EpiAct, StaticOrder>(llds, g, S, E); }
    SEAM();
    { GV(); rows_resnorm<1, true>(ZB, HP, a.in[17], 1.0f, OG, XN, nullptr, gi, GG, TG); }
    SEAM();
    { GV(); Gemm g{XN, W2IN, TG, 2 * FF, DM}; StaticOrder S; S.init(TG, 2 * FF, GG, gi); EpiSwiglu E{ZB, FF}; gemm_phase<EpiSwiglu, StaticOrder>(llds, g, S, E); }
    SEAM();
    { GV(); Gemm g{ZB, W2OUT, TG, DM, FF}; StaticOrder S; S.init(TG, DM, GG, gi); EpiAct E{FB, DM, 0, nullptr, nullptr}; gemm_phase<EpiAct, StaticOrder>(llds, g, S, E); }
    SEAM();
    if (((blockIdx.x >> 3) & 1) == 1) {
        if (threadIdx.x == 0) __hip_atomic_fetch_add((unsigned*)(ws + WS_CTL) + 3 * 4096 + 64, 1u, __ATOMIC_RELAXED, __HIP_MEMORY_SCOPE_AGENT);
        { GV(); rows_resnorm<1, false>(FB, OG, a.in[21], 0.5f, OUTF, nullptr, nullptr, (int)blockIdx.x, G, TG); }
    } else {
        { GV(); rows_resnorm<1, false>(FB, OG, a.in[21], 0.5f, OUTF, nullptr, nullptr, gi, GG, TG); }
        if (threadIdx.x == 0) { unsigned sp = 0; while (__hip_atomic_load((unsigned*)(ws + WS_CTL) + 3 * 4096 + 64, __ATOMIC_RELAXED, __HIP_MEMORY_SCOPE_AGENT) < (unsigned)GG && ++sp < (1u << 22)) __builtin_amdgcn_s_sleep(2);
            __builtin_amdgcn_fence(__ATOMIC_ACQUIRE, "agent"); asm volatile("s_waitcnt vmcnt(0)" ::: "memory"); }
        __syncthreads();
        { const size_t R1_ = (size_t)TG * DM;
          rows_resnorm<1, false>((bf16_t*)(ws + WS_F) + R1_, (bf16_t*)(ws + WS_OG) + R1_, a.in[21], 0.5f, a.out + R1_, nullptr, nullptr, (int)blockIdx.x, G, TG); }
    }
#undef BAR_ALL
#undef GV
#undef SEAM
}
}

extern "C" void kernel_launch(void* const* d_in, const int* in_sizes, int n_in, void* d_out, int out_size, void* d_ws, size_t ws_size, hipStream_t stream) {
    static int grid = 0;
    if (grid == 0) {
        if (n_in != 22 || in_sizes[0] != mk::T * mk::DM || out_size != mk::T * mk::DM || ws_size < mk::WS_END) {
            fprintf(stderr, "kernel_launch: built for 22 inputs, x/out of %d floats, >= %zu bytes of workspace; got n_in %d in0 %d out %d ws %zu\n", mk::T * mk::DM, (size_t)mk::WS_END, n_in, n_in > 0 ? in_sizes[0] : -1, out_size, ws_size);
            grid = -1; return; }
        int dev = 0, cus = 0, per_cu = 0;
        hipGetDevice(&dev); hipDeviceGetAttribute(&cus, hipDeviceAttributeMultiprocessorCount, dev);
        if (hipFuncSetAttribute((const void*)mk::mk_fwd, hipFuncAttributeMaxDynamicSharedMemorySize, mk::LDS_BYTES) != hipSuccess) { fprintf(stderr, "kernel_launch: hipFuncSetAttribute failed\n"); grid = -1; return; }
        if (hipOccupancyMaxActiveBlocksPerMultiprocessor(&per_cu, (const void*)mk::mk_fwd, 512, mk::LDS_BYTES) != hipSuccess || per_cu < 1) { fprintf(stderr, "kernel_launch: occupancy query says %d blocks per CU\n", per_cu); per_cu = 1; }
        (void)hipGetLastError();
        grid = cus;
        if (grid != 256) { fprintf(stderr, "kernel_launch: this build needs exactly 256 CUs (got %d)\n", grid); grid = -1; return; }
        fprintf(stderr, "kernel_launch: cus %d per_cu %d grid %d ws %zu\n", cus, per_cu, grid, ws_size);
    }
    if (grid < 0) return;
    mk::Args a{};
    for (int i = 0; i < 22; ++i) a.in[i] = (const float*)d_in[i];
    a.out = (float*)d_out; a.ws = (unsigned char*)d_ws;
    if (hipMemsetAsync((char*)d_ws + mk::WS_CTL, 0, 65536, stream) != hipSuccess) { fprintf(stderr, "kernel_launch: hipMemsetAsync failed\n"); return; }
#if MK_PER_PHASE
    for (int p = 0; p < mk::NPHASE; ++p) { a.ph_lo = p; a.ph_hi = p + 1; hipLaunchKernelGGL(mk::mk_fwd, dim3(grid), dim3(512), mk::LDS_BYTES, stream, a); }
#else
    a.ph_lo = 0; a.ph_hi = mk::NPHASE;
    void* args[] = {&a};
    hipError_t e = hipLaunchCooperativeKernel((const void*)mk::mk_fwd, dim3(grid), dim3(512), args, mk::LDS_BYTES, stream);
    if (e != hipSuccess) fprintf(stderr, "kernel_launch: cooperative launch failed: %s (grid %d)\n", hipGetErrorString(e), grid);
#endif
}
```

```cpp
#include <hip/hip_runtime.h>
#include <hip/hip_bf16.h>
#include <hip/hip_cooperative_groups.h>
#include <cstdio>
#include <cstdint>
namespace cg = cooperative_groups;

#ifndef MK_PER_PHASE
#define MK_PER_PHASE 0
#endif

namespace pg8 {
#define PG8_LAS __attribute__((address_space(3)))
typedef unsigned short bf16_t;
typedef short bf16x8 __attribute__((ext_vector_type(8)));
typedef float f32x4 __attribute__((ext_vector_type(4)));
typedef unsigned u32x4 __attribute__((ext_vector_type(4)));
constexpr int BM = 256, BK = 64, HALF = 128, HTB = HALF * BK * 2  , STAGE_BYTES = 8 * HTB, NXCD = 8, WGM = 8;

__host__ __device__ __forceinline__ int lds_byte(int r, int c) { const int st = (r >> 4) * 2 + (c >> 5), rr = r & 15, cc = c & 31, ob = rr * 64 + cc * 2; return st * 1024 + (ob ^ (((ob >> 9) & 1) << 5)); }
__host__ __device__ __forceinline__ void stage_rc(int b, int& R, int& C) { const int st = b / 1024, sb = b % 1024, swz = sb ^ (((sb >> 9) & 1) << 5); R = (st >> 1) * 16 + swz / 64; C = (st & 1) * 32 + (swz % 64) / 2; }
__host__ __device__ __forceinline__ int perm32(int rho) { const int n = rho >> 4, i = rho & 15; return 8 * (i >> 2) + 4 * n + (i & 3); }

struct Unit { int pm, pn; };
struct Gemm { const bf16_t* A; const bf16_t* Bt; int M, N, K; };

struct StaticOrder {
    int nM, nN, nwg, G, c;
    __host__ __device__ void init(int M, int N, int G_, int c_) { nM = M / BM; nN = N / BM; nwg = nM * nN; G = G_; c = c_; }
    __host__ __device__ bool next(int i, Unit& u) const {
        const long L = (long)i * G + c; if (L >= nwg) return false;
        int wgid = (int)L; { const int q = nwg / NXCD, r = nwg % NXCD, xcd = wgid % NXCD, off = wgid / NXCD; wgid = (xcd < r ? xcd * (q + 1) : r * (q + 1) + (xcd - r) * q) + off; }
        const int nig = WGM * nN, gid = wgid / nig, fm = gid * WGM, gsz = (nM - fm) < WGM ? (nM - fm) : WGM;
        u.pm = fm + ((wgid % nig) % gsz); u.pn = (wgid % nig) / gsz; return true;
    }
    __device__ __forceinline__ void a_ready(const Unit&) const {}
    __device__ __forceinline__ void done(const Unit&) const {}
};
__device__ __forceinline__ unsigned cvt_pk_bf16(float lo, float hi) { unsigned r; asm volatile("v_cvt_pk_bf16_f32 %0, %1, %2" : "=v"(r) : "v"(lo), "v"(hi)); return r; }
typedef float f32x2 __attribute__((ext_vector_type(2)));

__device__ __forceinline__ float fsigmoid(float x) { return __builtin_amdgcn_rcpf(1.0f + __expf(-x)); }
__device__ __forceinline__ float fsilu(float x) { return x * fsigmoid(x); }
__device__ __forceinline__ f32x4 sigmoid4(f32x4 x) {
    f32x4 d;
#pragma unroll
    for (int j = 0; j < 4; ++j) d[j] = 1.0f + __expf(-fmaxf(x[j], -20.0f));
    const float p01 = d[0] * d[1], p23 = d[2] * d[3], r = __builtin_amdgcn_rcpf(p01 * p23), r01 = r * p23, r23 = r * p01;
    return (f32x4){r01 * d[1], r01 * d[0], r23 * d[3], r23 * d[2]};
}
__device__ __forceinline__ float flogsig16(float x) { return (fminf(x, 0.f) - __logf(1.0f + __expf(-fabsf(x)))) * 0.0625f; }
__device__ __forceinline__ float bf_lo(unsigned u) { return __uint_as_float(u << 16); }
__device__ __forceinline__ float bf_hi(unsigned u) { return __uint_as_float(u & 0xffff0000u); }

struct EpiAct {
    static constexpr bool PERM = true, AFTER_DRAIN = false;
    bf16_t* O; int ldc; int mode; const float* bias_f; const float* bias_b;
    __device__ __forceinline__ void operator()(const f32x4 (&acc)[2][2][4][2], const Unit& u, int wr, int wc, int fr, int fq) const {
        int act = 0; const float* bias = nullptr;
        if (mode == 1) { if (u.pn >= 8 && u.pn < 12) act = 1; else if (u.pn >= 12) { act = 3; bias = (u.pn >= 14) ? bias_b + (u.pn - 14) * 256 : bias_f + (u.pn - 12) * 256; } }
        else if (mode == 2) { if (u.pn >= 6) act = 2; }
        const int row0 = u.pm * BM + wr * 64 + fr, col0 = u.pn * BM + wc * 32 + 8 * fq, bcol0 = wc * 32 + 8 * fq;
        f32x4 bv[2][2];
#pragma unroll
        for (int bj = 0; bj < 2; ++bj)
#pragma unroll
            for (int n = 0; n < 2; ++n) bv[bj][n] = bias ? *(const f32x4*)(bias + bcol0 + bj * HALF + 4 * n) : (f32x4){0.f, 0.f, 0.f, 0.f};
#pragma unroll
        for (int ai = 0; ai < 2; ++ai)
#pragma unroll
            for (int m = 0; m < 4; ++m) { bf16_t* rowp = O + (size_t)(row0 + ai * HALF + m * 16) * ldc + col0;
#pragma unroll
                for (int bj = 0; bj < 2; ++bj) { f32x4 v0 = acc[ai][bj][m][0] + bv[bj][0], v1 = acc[ai][bj][m][1] + bv[bj][1];
                    if (act == 1) {
#pragma unroll
                        for (int j = 0; j < 1; ++j) { v0 = v0 * sigmoid4(v0); v1 = v1 * sigmoid4(v1); } }
                    else if (act == 2) {
#pragma unroll
                        for (int j = 0; j < 1; ++j) { v0 = sigmoid4(v0); v1 = sigmoid4(v1); } }
                    else if (act == 3) {
#pragma unroll
                        for (int j = 0; j < 4; ++j) { v0[j] = flogsig16(v0[j]); v1[j] = flogsig16(v1[j]); } }
                    u32x4 w; w.x = cvt_pk_bf16(v0[0], v0[1]); w.y = cvt_pk_bf16(v0[2], v0[3]); w.z = cvt_pk_bf16(v1[0], v1[1]); w.w = cvt_pk_bf16(v1[2], v1[3]);
                    *(u32x4*)(rowp + bj * HALF) = w; } }
    }
};
struct EpiSwiglu {
    static constexpr bool PERM = true, AFTER_DRAIN = false;
    bf16_t* O; int ldc;
    __device__ __forceinline__ void operator()(const f32x4 (&acc)[2][2][4][2], const Unit& u, int wr, int wc, int fr, int fq) const {
        const int row0 = u.pm * BM + wr * 64 + fr, col0 = u.pn * HALF + wc * 32 + 8 * fq;
#pragma unroll
        for (int ai = 0; ai < 2; ++ai)
#pragma unroll
            for (int m = 0; m < 4; ++m) { bf16_t* rowp = O + (size_t)(row0 + ai * HALF + m * 16) * ldc + col0;
                f32x4 v0, v1;
#pragma unroll
                for (int j = 0; j < 1; ++j) { v0 = acc[ai][0][m][0] * sigmoid4(acc[ai][0][m][0]) * acc[ai][1][m][0]; v1 = acc[ai][0][m][1] * sigmoid4(acc[ai][0][m][1]) * acc[ai][1][m][1]; }
                u32x4 w; w.x = cvt_pk_bf16(v0[0], v0[1]); w.y = cvt_pk_bf16(v0[2], v0[3]); w.z = cvt_pk_bf16(v1[0], v1[1]); w.w = cvt_pk_bf16(v1[2], v1[3]);
                *(u32x4*)rowp = w; }
    }
};
template <bool ACCUM> struct EpiGate {
    static constexpr bool PERM = true, AFTER_DRAIN = false;
    bf16_t* O; int ldc; const bf16_t* G; int ldg;
    __device__ __forceinline__ void operator()(const f32x4 (&acc)[2][2][4][2], const Unit& u, int wr, int wc, int fr, int fq) const {
        const int row0 = u.pm * BM + wr * 64 + fr, col0 = u.pn * BM + wc * 32 + 8 * fq;
#pragma unroll
        for (int ai = 0; ai < 2; ++ai)
#pragma unroll
            for (int m = 0; m < 4; ++m) { const size_t r = (size_t)(row0 + ai * HALF + m * 16); bf16_t* rowp = O + r * ldc + col0; const bf16_t* gp = G + r * ldg + col0;
#pragma unroll
                for (int bj = 0; bj < 2; ++bj) { const u32x4 gw = *(const u32x4*)(gp + bj * HALF);
                    f32x4 v0 = acc[ai][bj][m][0], v1 = acc[ai][bj][m][1];
                    v0[0] *= bf_lo(gw.x); v0[1] *= bf_hi(gw.x); v0[2] *= bf_lo(gw.y); v0[3] *= bf_hi(gw.y);
                    v1[0] *= bf_lo(gw.z); v1[1] *= bf_hi(gw.z); v1[2] *= bf_lo(gw.w); v1[3] *= bf_hi(gw.w);
                    if (ACCUM) { const u32x4 pw = *(const u32x4*)(rowp + bj * HALF);
                        v0[0] += bf_lo(pw.x); v0[1] += bf_hi(pw.x); v0[2] += bf_lo(pw.y); v0[3] += bf_hi(pw.y);
                        v1[0] += bf_lo(pw.z); v1[1] += bf_hi(pw.z); v1[2] += bf_lo(pw.w); v1[3] += bf_hi(pw.w); }
                    u32x4 w; w.x = cvt_pk_bf16(v0[0], v0[1]); w.y = cvt_pk_bf16(v0[2], v0[3]); w.z = cvt_pk_bf16(v1[0], v1[1]); w.w = cvt_pk_bf16(v1[2], v1[3]);
                    *(u32x4*)(rowp + bj * HALF) = w; } }
    }
};

template <class Epi, class Sched>
__device__ __forceinline__ void gemm_phase(PG8_LAS unsigned char* lds, const Gemm g, const Sched& S, const Epi& E) {
    int tid_ = threadIdx.x; asm volatile("" : "+v"(tid_));
    const int tid = tid_, wid = __builtin_amdgcn_readfirstlane(tid >> 6), lane = tid & 63, wr = wid >> 2, wc = wid & 3, fr = lane & 15, fq = lane >> 4;
    const int K = g.K, nt = K / BK;
    unsigned voffA[2], voffB[2];
#pragma unroll
    for (int i = 0; i < 2; ++i) { int R, C; stage_rc(tid * 16 + i * 8192, R, C); const int Rb = Epi::PERM ? ((R & ~31) + perm32(R & 31)) : R;
        voffA[i] = (unsigned)(R * K + C) * 2u; voffB[i] = (unsigned)(Rb * K + C) * 2u; }
    const size_t kstep = (size_t)(BK * 2);
    const size_t hstep = (size_t)HALF * K * 2;
    const size_t tstep = 2 * hstep;
    const unsigned ldsw = (unsigned)wid * 1024u;
    const int aoff = lds_byte(wr * 64 + fr, fq * 8), boff = lds_byte(wc * 32 + fr, fq * 8);
#define PG8_SA(b, h) (((b) * 2 + (h)) * HTB)
#define PG8_SB(b, h) ((4 + (b) * 2 + (h)) * HTB)
#define PG8_STAGE(bufoff, gbase, voff) do { _Pragma("unroll") for (int _i = 0; _i < 2; ++_i) \
        __builtin_amdgcn_global_load_lds((const unsigned*)((const char*)(gbase) + (voff)[_i]), (PG8_LAS unsigned*)(lds + (bufoff) + ldsw + _i * 8192), 16, 0, 0); } while (0)
#define PG8_LDA(dst, b, h) do { _Pragma("unroll") for (int m = 0; m < 4; ++m) _Pragma("unroll") for (int k = 0; k < 2; ++k) dst[m][k] = *(const PG8_LAS bf16x8*)(lds + PG8_SA(b, h) + aoff + m * 2048 + k * 1024); } while (0)
#define PG8_LDB(dst, b, h) do { _Pragma("unroll") for (int n = 0; n < 2; ++n) _Pragma("unroll") for (int k = 0; k < 2; ++k) dst[n][k] = *(const PG8_LAS bf16x8*)(lds + PG8_SB(b, h) + boff + n * 2048 + k * 1024); } while (0)
#define PG8_MMA(ai, bj, At, Bt) do { __builtin_amdgcn_s_setprio(1); _Pragma("unroll") for (int m = 0; m < 4; ++m) _Pragma("unroll") for (int n = 0; n < 2; ++n) _Pragma("unroll") for (int k = 0; k < 2; ++k) \
        acc[ai][bj][m][n] = __builtin_amdgcn_mfma_f32_16x16x32_bf16(Bt[n][k], At[m][k], acc[ai][bj][m][n], 0, 0, 0); __builtin_amdgcn_s_setprio(0); } while (0)
#define PG8_WAIT_V(n) asm volatile("s_waitcnt vmcnt(" #n ")" ::: "memory")
#define PG8_WAIT_L(n) asm volatile("s_waitcnt lgkmcnt(" #n ")" ::: "memory")
#define PG8_BAR __builtin_amdgcn_s_barrier()
#define PG8_SCHED __builtin_amdgcn_sched_barrier(0)
    Unit cur, nxt; int ui = 0;
    if (!S.next(0, cur)) return;
    f32x4 acc[2][2][4][2];
#pragma unroll
    for (int a = 0; a < 2; ++a)
#pragma unroll
        for (int b = 0; b < 2; ++b)
#pragma unroll
            for (int m = 0; m < 4; ++m)
#pragma unroll
                for (int n = 0; n < 2; ++n) acc[a][b][m][n] = (f32x4){0.f, 0.f, 0.f, 0.f};
    bf16x8 At[4][2], B0[2][2], B1[2][2];
    const char* cA = (const char*)g.A + (size_t)cur.pm * tstep; const char* cB = (const char*)g.Bt + (size_t)cur.pn * tstep;
    S.a_ready(cur);
    PG8_STAGE(PG8_SB(0, 0), cB, voffB); PG8_STAGE(PG8_SA(0, 0), cA, voffA); PG8_STAGE(PG8_SB(0, 1), cB + hstep, voffB); PG8_STAGE(PG8_SA(0, 1), cA + hstep, voffA);
    if (wr == 1) PG8_BAR;
    PG8_WAIT_V(4); PG8_BAR;
    PG8_STAGE(PG8_SB(1, 0), cB + kstep, voffB); PG8_STAGE(PG8_SA(1, 0), cA + kstep, voffA); PG8_STAGE(PG8_SB(1, 1), cB + hstep + kstep, voffB);
    PG8_WAIT_V(6); PG8_BAR;
    for (;;) {
        const bool has_next = S.next(ui + 1, nxt);
        const char* nA = has_next ? (const char*)g.A + (size_t)nxt.pm * tstep : cA; const char* nB = has_next ? (const char*)g.Bt + (size_t)nxt.pn * tstep : cB;
        for (int t = 0; t < nt; t += 2) {
            const bool last = (t == nt - 2);
            const char* a1 = cA + (size_t)(t + 1) * kstep;
            const char* a2 = last ? nA : cA + (size_t)(t + 2) * kstep; const char* b2 = last ? nB : cB + (size_t)(t + 2) * kstep;
            const char* a3 = a2 + kstep; const char* b3 = b2 + kstep;
            if (last && has_next) S.a_ready(nxt);
            PG8_LDB(B0, 0, 0); PG8_SCHED; PG8_LDA(At, 0, 0); PG8_STAGE(PG8_SA(1, 1), a1 + hstep, voffA);
            PG8_WAIT_L(8); PG8_BAR; PG8_WAIT_L(0); PG8_MMA(0, 0, At, B0); PG8_BAR; PG8_SCHED;
            PG8_LDB(B1, 0, 1); PG8_STAGE(PG8_SB(0, 0), b2, voffB);
            PG8_BAR; PG8_WAIT_L(0); PG8_MMA(0, 1, At, B1); PG8_BAR;
            PG8_LDA(At, 0, 1); PG8_STAGE(PG8_SA(0, 0), a2, voffA);
            PG8_BAR; PG8_WAIT_L(0); PG8_MMA(1, 0, At, B0); PG8_BAR; PG8_SCHED;
            PG8_STAGE(PG8_SB(0, 1), b2 + hstep, voffB);
            PG8_WAIT_V(6); PG8_BAR; PG8_MMA(1, 1, At, B1); PG8_BAR;
            PG8_LDB(B0, 1, 0); PG8_SCHED; PG8_LDA(At, 1, 0); PG8_STAGE(PG8_SA(0, 1), a2 + hstep, voffA);
            PG8_WAIT_L(8); PG8_BAR; PG8_WAIT_L(0); PG8_MMA(0, 0, At, B0); PG8_BAR; PG8_SCHED;
            PG8_LDB(B1, 1, 1); PG8_STAGE(PG8_SB(1, 0), b3, voffB);
            PG8_BAR; PG8_WAIT_L(0); PG8_MMA(0, 1, At, B1); PG8_BAR;
            PG8_LDA(At, 1, 1); PG8_STAGE(PG8_SA(1, 0), a3, voffA);
            PG8_BAR; PG8_WAIT_L(0); PG8_MMA(1, 0, At, B0); PG8_BAR; PG8_SCHED;
            PG8_STAGE(PG8_SB(1, 1), b3 + hstep, voffB);
            PG8_WAIT_V(6); PG8_BAR; PG8_MMA(1, 1, At, B1); PG8_BAR;
        }
        if constexpr (!Epi::AFTER_DRAIN) { E(acc, cur, wr, wc, fr, fq); S.done(cur); }
        if (!has_next) break;
#pragma unroll
        for (int a = 0; a < 2; ++a)
#pragma unroll
            for (int b = 0; b < 2; ++b)
#pragma unroll
                for (int m = 0; m < 4; ++m)
#pragma unroll
                    for (int n = 0; n < 2; ++n) acc[a][b][m][n] = (f32x4){0.f, 0.f, 0.f, 0.f};
        cur = nxt; cA = nA; cB = nB; ++ui;
    }
    PG8_WAIT_V(0);
    if (wr == 0) PG8_BAR;
    PG8_BAR;
    if constexpr (Epi::AFTER_DRAIN) { E.fused(acc, cur, wr, wc, fr, fq, lds, wid, lane); S.done(cur); }
#undef PG8_SA
#undef PG8_SB
#undef PG8_STAGE
#undef PG8_LDA
#undef PG8_LDB
#undef PG8_MMA
#undef PG8_WAIT_V
#undef PG8_WAIT_L
#undef PG8_BAR
#undef PG8_SCHED
}
}

namespace attn {
using bf16 = __hip_bfloat16;
constexpr int   D = 128, NW = 8, QBLK = 32, KVBLK = 64;
constexpr float SCALE = 0.088388347648318440f;
constexpr float THR = 8.f;
constexpr int SDEPTH = 2;
constexpr int LDQ = 3584, LDK = 3584, LDO = 1024;
constexpr size_t SHM_V = KVBLK * D * 2, SHM_K = KVBLK * D * 2, SHM_ATTN = 2 * SHM_V + 2 * SHM_K + NW * 64 * 4;
__device__ __forceinline__ unsigned short f2bf_rne(float f) { unsigned u = __float_as_uint(f); u += 0x7FFFu + ((u >> 16) & 1u); return (unsigned short)(u >> 16); }
using bf16x8 = __attribute__((ext_vector_type(8))) short;
using s16x4  = __attribute__((ext_vector_type(4))) short;
using f32x16 = __attribute__((ext_vector_type(16))) float;
using f32x8  = __attribute__((ext_vector_type(8))) float;
using u32x4  = __attribute__((ext_vector_type(4))) unsigned;
#define KSWZ(row, colB) ((row) * 256 + ((colB) ^ (((row) & 7) << 4)))
#define SBAR() __builtin_amdgcn_sched_barrier(0)
__device__ __forceinline__ int crow(int r, int hi) { return (r & 3) + 8 * (r >> 2) + 4 * hi; }
__device__ __forceinline__ unsigned cvtpk(float lo, float hi) {
  unsigned r; asm volatile("v_cvt_pk_bf16_f32 %0, %1, %2" : "=v"(r) : "v"(lo), "v"(hi)); return r;
}
template <typename TIn> struct Stage;
template <> struct Stage<bf16>  { using T = bf16x8;
  __device__ static __forceinline__ T ld8(const bf16* p) { return *reinterpret_cast<const bf16x8*>(p); }
  __device__ static __forceinline__ bf16x8 tobf(T x) { return x; } };
template <> struct Stage<float> { using T = f32x8;
  __device__ static __forceinline__ T ld8(const float* p) { return *reinterpret_cast<const f32x8*>(p); }
  __device__ static __forceinline__ bf16x8 tobf(T x) {
    u32x4 w = {cvtpk(x[0], x[1]), cvtpk(x[2], x[3]), cvtpk(x[4], x[5]), cvtpk(x[6], x[7])}; return *reinterpret_cast<bf16x8*>(&w); } };

__device__ __forceinline__ void partialSM(f32x16& p0, f32x16& p1, float& m_reg, float& mn, float& alpha) {
  constexpr float C = SCALE * 1.4426950408889634f;
  float pmax = p0[0]; for (int r = 1; r < 16; ++r) pmax = fmaxf(pmax, p0[r]); for (int r = 0; r < 16; ++r) pmax = fmaxf(pmax, p1[r]);
  { auto rr = __builtin_amdgcn_permlane32_swap(__float_as_uint(pmax), __float_as_uint(pmax), false, false);
    pmax = fmaxf(__uint_as_float(rr[0]), __uint_as_float(rr[1])); }
  if (__builtin_expect(__all(pmax - m_reg <= THR / SCALE), 1)) { mn = m_reg; alpha = 1.f; }
  else { mn = fmaxf(m_reg, pmax); alpha = __builtin_amdgcn_exp2f((m_reg - mn) * C); m_reg = mn; }
  float mnC = -mn * C;
  for (int r = 0; r < 16; ++r) p0[r] = fmaf(p0[r], C, mnC); for (int r = 0; r < 16; ++r) p1[r] = fmaf(p1[r], C, mnC);
  for (int r = 0; r < 16; ++r) p0[r] = __builtin_amdgcn_exp2f(p0[r]);
}
__device__ __forceinline__ void finishSM(f32x16& p0, f32x16& p1, float alpha, float& l_reg, bf16x8& pa0, bf16x8& pa1, bf16x8& pa2, bf16x8& pa3) {
  for (int r = 0; r < 16; ++r) p1[r] = __builtin_amdgcn_exp2f(p1[r]);
  float ps = 0; for (int r = 0; r < 16; ++r) ps += p0[r]; for (int r = 0; r < 16; ++r) ps += p1[r];
  { auto rr = __builtin_amdgcn_permlane32_swap(__float_as_uint(ps), __float_as_uint(ps), false, false);
    ps = __uint_as_float(rr[0]) + __uint_as_float(rr[1]); }
  l_reg = l_reg * alpha + ps;
#define PK4(P, BASE, OUT) do { unsigned a0 = cvtpk(P[BASE + 0], P[BASE + 1]), a1 = cvtpk(P[BASE + 2], P[BASE + 3]);   \
    unsigned b0 = cvtpk(P[BASE + 4], P[BASE + 5]), b1 = cvtpk(P[BASE + 6], P[BASE + 7]);                              \
    auto r0 = __builtin_amdgcn_permlane32_swap(a0, b0, false, false); auto r1 = __builtin_amdgcn_permlane32_swap(a1, b1, false, false); \
    u32x4 w = {r0[0], r1[0], r0[1], r1[1]}; OUT = *reinterpret_cast<bf16x8*>(&w); } while (0)
  PK4(p0, 0, pa0); PK4(p0, 8, pa1); PK4(p1, 0, pa2); PK4(p1, 8, pa3);
#undef PK4
}
__device__ __forceinline__ void qkt(f32x16& p0, f32x16& p1, const bf16* Ks, const bf16x8* qr, int r32, int hi) {
  p0 = f32x16{}; p1 = f32x16{};
  for (int d0 = 0; d0 < 8; ++d0) { int cb = (d0 * 16 + hi * 8) * 2;
    bf16x8 b0 = *reinterpret_cast<const bf16x8*>((const char*)Ks + KSWZ(r32, cb));
    bf16x8 b1 = *reinterpret_cast<const bf16x8*>((const char*)Ks + KSWZ(32 + r32, cb));
    p0 = __builtin_amdgcn_mfma_f32_32x32x16_bf16(b0, qr[d0], p0, 0, 0, 0);
    p1 = __builtin_amdgcn_mfma_f32_32x32x16_bf16(b1, qr[d0], p1, 0, 0, 0); }
}
__device__ __forceinline__ int v_st(int k, int c) { const int kk = (k & ~0xC) | ((k & 4) << 1) | ((k & 8) >> 1); return ((kk >> 3) * 4 + (c >> 5)) * 512 + ((kk & 7) * 32 + (c & 31)) * 2; }
__device__ __forceinline__ int v_rd_base(int lane) { return ((lane & 3) << 3) | (((lane >> 2) & 3) << 6) | (((lane >> 4) & 1) << 5) | (((lane >> 5) & 1) << 8); }
constexpr int v_rd_off(int d0, int ks, int half) { return d0 * 512 + ks * 4096 + half * 2048; }
template <int OFF> __device__ __forceinline__ s16x4 tr_read(int vb) {
  s16x4 r; asm volatile("ds_read_b64_tr_b16 %0, %1 offset:%2" : "=&v"(r) : "v"(vb), "i"(OFF) : "memory"); return r;
}
template <int D0> __device__ __forceinline__ void pv_one(f32x16& od, int vb, bf16x8 pa0, bf16x8 pa1, bf16x8 pa2, bf16x8 pa3) {
  const s16x4 l0 = tr_read<v_rd_off(D0, 0, 0)>(vb), h0 = tr_read<v_rd_off(D0, 0, 1)>(vb), l1 = tr_read<v_rd_off(D0, 1, 0)>(vb), h1 = tr_read<v_rd_off(D0, 1, 1)>(vb);
  const s16x4 l2 = tr_read<v_rd_off(D0, 2, 0)>(vb), h2 = tr_read<v_rd_off(D0, 2, 1)>(vb), l3 = tr_read<v_rd_off(D0, 3, 0)>(vb), h3 = tr_read<v_rd_off(D0, 3, 1)>(vb);
  asm volatile("s_waitcnt lgkmcnt(0)" ::: "memory"); SBAR();
#define PK(L, H) (bf16x8){L[0], L[1], L[2], L[3], H[0], H[1], H[2], H[3]}
  od = __builtin_amdgcn_mfma_f32_32x32x16_bf16(pa0, PK(l0, h0), od, 0, 0, 0);
  od = __builtin_amdgcn_mfma_f32_32x32x16_bf16(pa1, PK(l1, h1), od, 0, 0, 0);
  od = __builtin_amdgcn_mfma_f32_32x32x16_bf16(pa2, PK(l2, h2), od, 0, 0, 0);
  od = __builtin_amdgcn_mfma_f32_32x32x16_bf16(pa3, PK(l3, h3), od, 0, 0, 0);
#undef PK
}
__device__ __forceinline__ void pv_d0(f32x16* o, int vb, bf16x8 pa0, bf16x8 pa1, bf16x8 pa2, bf16x8 pa3) {
  pv_one<0>(o[0], vb, pa0, pa1, pa2, pa3); pv_one<1>(o[1], vb, pa0, pa1, pa2, pa3); pv_one<2>(o[2], vb, pa0, pa1, pa2, pa3); pv_one<3>(o[3], vb, pa0, pa1, pa2, pa3);
}

template <typename TQ>
__device__ __forceinline__ void attn_dense_body(const TQ* __restrict__ Qb, const bf16* __restrict__ Kh, const bf16* __restrict__ Vh,
                                                unsigned short* __restrict__ Ob, int seq, char* lds, const float* __restrict__ qg, int pos0) {
  using St = Stage<bf16>; using SQ = Stage<TQ>;
  int tid_ = threadIdx.x; asm volatile("" : "+v"(tid_));
  const int tid = tid_, wid = tid >> 6, lane = tid & 63, r32 = lane & 31, hi = lane >> 5;
  bf16* V_lds = (bf16*)lds; bf16* K_lds = (bf16*)(lds + 2 * SHM_V);
  float* ws = (float*)(lds + 2 * SHM_V + 2 * SHM_K) + wid * 64; float* li_l = ws; float* al_l = ws + 32;
  float m_reg = -1e30f, l_reg = 0; f32x16 o[4] = {}; bf16x8 qr[8];
  const TQ* Qw = Qb + (long)(wid * QBLK + r32) * LDQ + hi * 8;
#pragma unroll
  for (int d0 = 0; d0 < 8; ++d0) qr[d0] = SQ::tobf(SQ::ld8(Qw + d0 * 16));
  {
#define QF(d0, jj) __uint_as_float(((unsigned)(unsigned short)qr[d0][jj]) << 16)
    int hi2 = hi; asm volatile("" : "+v"(hi2));
    const float* qg2 = qg; asm volatile("" : "+s"(qg2));
    float ss = 0.f;
#pragma unroll
    for (int d0 = 0; d0 < 8; ++d0)
#pragma unroll
      for (int jj = 0; jj < 8; ++jj) { const float x = QF(d0, jj); ss += x * x; }
    ss += __shfl_xor(ss, 32);
    const float ri = rsqrtf(ss * (1.0f / 128.0f) + 1e-6f);
    const int pos = pos0 + wid * QBLK + r32; const float prow = (float)(pos >> 6), pcol = (float)(pos & 63);
    u32x4 qv[8];
#pragma unroll
    for (int d0 = 0; d0 < 8; ++d0) qv[d0] = *reinterpret_cast<u32x4*>(&qr[d0]);
#pragma unroll
    for (int dd = 0; dd < 2; ++dd)
#pragma unroll
      for (int jp = 0; jp < 4; ++jp) { float o[4][2];
#pragma unroll
        for (int u = 0; u < 2; ++u) { const int jj = 2 * jp + u, e0 = 16 * dd + 8 * hi2 + jj;
          const float invf = exp2f(-(float)e0 * (13.287712379549449f / 32.0f));
          const float ar = prow * invf, ac = pcol * invf;
          const float sr_ = __sinf(ar), cr_ = __cosf(ar), sc_ = __sinf(ac), cc_ = __cosf(ac);
#define QW(d0) (u ? __uint_as_float(qv[d0][jp] & 0xffff0000u) : __uint_as_float(qv[d0][jp] << 16))
          const float a1 = QW(dd) * ri * qg2[e0], a2 = QW(dd + 2) * ri * qg2[32 + e0], b1 = QW(4 + dd) * ri * qg2[64 + e0], b2 = QW(6 + dd) * ri * qg2[96 + e0];
#undef QW
          o[0][u] = a1 * cr_ - a2 * sr_; o[1][u] = a2 * cr_ + a1 * sr_; o[2][u] = b1 * cc_ - b2 * sc_; o[3][u] = b2 * cc_ + b1 * sc_; }
        qv[dd][jp] = cvtpk(o[0][0], o[0][1]); qv[dd + 2][jp] = cvtpk(o[1][0], o[1][1]); qv[4 + dd][jp] = cvtpk(o[2][0], o[2][1]); qv[6 + dd][jp] = cvtpk(o[3][0], o[3][1]); }
#pragma unroll
    for (int d0 = 0; d0 < 8; ++d0) qr[d0] = *reinterpret_cast<bf16x8*>(&qv[d0]);
#undef QF
  }
  const int sr = tid >> 4, sc = (tid & 15) * 8, vst0 = v_st(sr, sc), vst1 = v_st(32 + sr, sc);
  const int vb0 = (int)(uintptr_t)V_lds + v_rd_base(lane);
  struct { typename St::T vs0, vs1, ks0, ks1; } sr_[SDEPTH];
#define SLOAD(i, k0) do { sr_[i].vs0 = St::ld8(&Vh[(long)((k0) + sr) * LDK + sc]); sr_[i].vs1 = St::ld8(&Vh[(long)((k0) + 32 + sr) * LDK + sc]); \
    sr_[i].ks0 = St::ld8(&Kh[(long)((k0) + sr) * LDK + sc]); sr_[i].ks1 = St::ld8(&Kh[(long)((k0) + 32 + sr) * LDK + sc]); } while (0)
#define SWRITE(b, i) do { *(bf16x8*)((char*)V_lds + (b) * SHM_V + vst0) = St::tobf(sr_[i].vs0);          \
    *(bf16x8*)((char*)V_lds + (b) * SHM_V + vst1) = St::tobf(sr_[i].vs1); int kc = sc * 2;               \
    *(bf16x8*)((char*)K_lds + (b) * SHM_K + KSWZ(sr, kc)) = St::tobf(sr_[i].ks0);                       \
    *(bf16x8*)((char*)K_lds + (b) * SHM_K + KSWZ(32 + sr, kc)) = St::tobf(sr_[i].ks1); } while (0)
#define SWAIT() do { if constexpr (SDEPTH == 2) asm volatile("s_waitcnt vmcnt(4)" ::: "memory"); else asm volatile("s_waitcnt vmcnt(0)" ::: "memory"); } while (0)
#define RESC(a) do { if (__any((a) < 1.f)) { if (hi == 0) al_l[r32] = (a); asm volatile("s_waitcnt lgkmcnt(0)" ::: "memory"); \
    for (int d = 0; d < 4; ++d) for (int r = 0; r < 16; ++r) o[d][r] *= al_l[crow(r, hi)]; } } while (0)
  f32x16 pA0, pA1, pB0, pB1; float mnA, mnB, alA, alB; bf16x8 pa0, pa1, pa2, pa3; const int NT = seq / KVBLK;
  constexpr int SE = 0, SO = SDEPTH - 1;
  SLOAD(SE, 0); asm volatile("s_waitcnt vmcnt(0)" ::: "memory"); SWRITE(0, SE); __syncthreads();
  qkt(pA0, pA1, K_lds, qr, r32, hi); partialSM(pA0, pA1, m_reg, mnA, alA);
  SLOAD(SO, KVBLK); if constexpr (SDEPTH == 2) { if (2 < NT) SLOAD(SE, 2 * KVBLK); }
  SWAIT(); SWRITE(1, SO); __syncthreads();
  for (int j = 1; j + 1 < NT; j += 2) {
    SBAR(); qkt(pB0, pB1, (bf16*)((char*)K_lds + SHM_K), qr, r32, hi);
    finishSM(pA0, pA1, alA, l_reg, pa0, pa1, pa2, pa3); SBAR();
    SLOAD(SO, (j + SDEPTH) * KVBLK); SBAR();
    pv_d0(o, vb0, pa0, pa1, pa2, pa3); partialSM(pB0, pB1, m_reg, mnB, alB);
    __syncthreads(); SWAIT(); SWRITE(0, SE);
    RESC(alB); __syncthreads();
    SBAR(); qkt(pA0, pA1, K_lds, qr, r32, hi);
    finishSM(pB0, pB1, alB, l_reg, pa0, pa1, pa2, pa3); SBAR();
    if (SDEPTH == 1 || j + 3 < NT) SLOAD(SE, (j + 1 + SDEPTH) * KVBLK); SBAR();
    pv_d0(o, vb0 + (int)SHM_V, pa0, pa1, pa2, pa3); partialSM(pA0, pA1, m_reg, mnA, alA);
    __syncthreads(); SWAIT(); SWRITE(1, SO);
    RESC(alA); __syncthreads();
  }
  SBAR(); qkt(pB0, pB1, (bf16*)((char*)K_lds + SHM_K), qr, r32, hi);
  finishSM(pA0, pA1, alA, l_reg, pa0, pa1, pa2, pa3); SBAR();
  pv_d0(o, vb0, pa0, pa1, pa2, pa3); partialSM(pB0, pB1, m_reg, mnB, alB);
  __syncthreads(); RESC(alB);
  finishSM(pB0, pB1, alB, l_reg, pa0, pa1, pa2, pa3); SBAR();
  pv_d0(o, vb0 + (int)SHM_V, pa0, pa1, pa2, pa3);
  if (hi == 0) li_l[r32] = l_reg; asm volatile("s_waitcnt lgkmcnt(0)" ::: "memory");
  float rli[16];
#pragma unroll
  for (int r = 0; r < 16; ++r) rli[r] = __builtin_amdgcn_rcpf(li_l[crow(r, hi)]);
  unsigned short* Ow = Ob + (long)(wid * QBLK) * LDO;
#pragma unroll
  for (int r = 0; r < 16; ++r) { int orow = crow(r, hi);
    for (int d0 = 0; d0 < 4; ++d0) Ow[(long)orow * LDO + d0 * 32 + r32] = f2bf_rne(o[d0][r] * rli[r]); }
#undef SLOAD
#undef SWRITE
#undef SWAIT
#undef RESC
}
#undef KSWZ
#undef SBAR
}

#define XB_TMO      128
#define XB_XCNT(j)  (256  + 64 * (j))
#define XB_XSUB(j)  (1280 + 64 * (j))
#define XB_XGEN(j)  (2304 + 64 * (j))
#define XB_TOP      3328
#define XB_TOPGEN   3392
#define XCD_BAR_WORDS 3456
#define XB_SPIN_CAP (1u << 18)
#define LAS __attribute__((address_space(3)))

__device__ __forceinline__ unsigned xb_ld(unsigned* p)              { return __hip_atomic_load(p, __ATOMIC_RELAXED, __HIP_MEMORY_SCOPE_AGENT); }
__device__ __forceinline__ unsigned xb_add(unsigned* p, unsigned v) { return __hip_atomic_fetch_add(p, v, __ATOMIC_RELAXED, __HIP_MEMORY_SCOPE_AGENT); }
__device__ __forceinline__ unsigned xb_xcc_id() { return (unsigned)__builtin_amdgcn_s_getreg((3 << 11) | 20) & 0xFu; }
#define XB_SPIN(cond, bar) do { unsigned _sp = 0; while (cond) { __builtin_amdgcn_s_sleep(1); \
    if ((++_sp & 255u) == 0u) { if (xb_ld(&(bar)[XB_TMO])) break; if (_sp > XB_SPIN_CAP) { atomicAdd(&(bar)[XB_TMO], 1u); break; } } } } while (0)

struct XcdBarrier {
    unsigned* bar; unsigned x; unsigned gsz;
    volatile LAS unsigned* st;
};

__device__ __forceinline__ XcdBarrier xcd_barrier_post(unsigned* bar, volatile LAS unsigned* st) {
    XcdBarrier b; b.bar = bar; b.x = xb_xcc_id(); b.st = st;
    if (threadIdx.x == 0) (void)xb_add(&bar[XB_XCNT(b.x)], 1u);
    return b;
}
__device__ __forceinline__ void xcd_barrier_complete(unsigned* bar, unsigned x, unsigned& nloc, unsigned& nx, unsigned G) {
    unsigned sum, cnt, mine, sp = 0u;
    for (;;) {
        sum = 0u; cnt = 0u; mine = 0u;
#pragma unroll
        for (unsigned j = 0; j < 16; ++j) { const unsigned c = xb_ld(&bar[XB_XCNT(j)]); sum += c; cnt += (c > 0u) ? 1u : 0u; mine = (j == x) ? c : mine; }
        if (sum == G) break;
        __builtin_amdgcn_s_sleep(1);
        if ((++sp & 255u) == 0u) { if (xb_ld(&bar[XB_TMO])) break; if (sp > XB_SPIN_CAP) { atomicAdd(&bar[XB_TMO], 1u); break; } }
    }
    nloc = mine > 0u ? mine : 1u; nx = cnt > 0u ? cnt : 1u;
}

__device__ __forceinline__ void xcd_barrier(const XcdBarrier& b) {
    asm volatile("s_waitcnt vmcnt(0)" ::: "memory");
    __syncthreads();
    if (threadIdx.x == 0) {
        unsigned* bar = b.bar;
        __builtin_amdgcn_s_waitcnt(0);
        unsigned nloc = b.st[0], nx = b.st[1];
        if (nloc == 0u) { xcd_barrier_complete(bar, b.x, nloc, nx, b.gsz); b.st[0] = nloc; b.st[1] = nx; }
        const unsigned old = xb_add(&bar[XB_XSUB(b.x)], 1u);
        const unsigned gen = old / nloc;
        if (old + 1u == (gen + 1u) * nloc) {
            __builtin_amdgcn_fence(__ATOMIC_RELEASE, "agent");
            asm volatile("s_waitcnt vmcnt(0)" ::: "memory");
            const unsigned og = xb_add(&bar[XB_TOP], 1u);
            const unsigned tg = og / nx;
            if (og + 1u == (tg + 1u) * nx) xb_add(&bar[XB_TOPGEN], 1u);
            else XB_SPIN(xb_ld(&bar[XB_TOPGEN]) == tg, bar);
            __builtin_amdgcn_fence(__ATOMIC_ACQUIRE, "agent");
            xb_add(&bar[XB_XGEN(b.x)], 1u);
            asm volatile("s_waitcnt vmcnt(0)" ::: "memory");
        } else {
            XB_SPIN(xb_ld(&bar[XB_XGEN(b.x)]) == gen, bar);
            __builtin_amdgcn_fence(__ATOMIC_ACQUIRE, "agent");
            asm volatile("s_waitcnt vmcnt(0)" ::: "memory");
        }
    }
    __syncthreads();
}

namespace mk {
using pg8::bf16_t; using pg8::bf16x8; using pg8::f32x4; using pg8::u32x4; using pg8::cvt_pk_bf16; using pg8::bf_lo; using pg8::bf_hi;
typedef unsigned u32x2 __attribute__((ext_vector_type(2)));
constexpr int T = 32768, DM = 1024, FF = 2816, SEQ = 2048, NZ1 = 4096, NZ2 = 3584, NWIN = 6688;
constexpr float EPS = 1e-6f;
constexpr size_t MiB = (size_t)1 << 20, HMiB = (size_t)1 << 19;
constexpr size_t WS_W1IN = 0, WS_W1OUT = 11 * MiB, WS_WIN = 16 * MiB + HMiB, WS_WA = 31 * MiB + HMiB, WS_WB = 33 * MiB + HMiB, WS_WO = 35 * MiB + HMiB,
                 WS_W2IN = 37 * MiB + HMiB, WS_W2OUT = 48 * MiB + HMiB, WS_XN = 56 * MiB, WS_F = 120 * MiB, WS_Z = 184 * MiB, WS_OG = 440 * MiB, WS_CTL = 504 * MiB, WS_RN = 504 * MiB + 65536, WS_END = 504 * MiB + 65536 + 131072;
constexpr int LDS_BYTES = 149504 + 16;
#define LBAR() do { asm volatile("s_waitcnt lgkmcnt(0)" ::: "memory"); __builtin_amdgcn_s_barrier(); asm volatile("" ::: "memory"); } while (0)

__device__ __forceinline__ float wave_sum(float v) {
#pragma unroll
    for (int o = 32; o > 0; o >>= 1) v += __shfl_xor(v, o);
    return v;
}

enum { CM_ID = 0, CM_SWIGLU = 1, CM_WIN_A = 2, CM_WIN_B = 3, CM_FOLD = 4 };
__device__ __forceinline__ void cvt_job(int& tbase, const float* __restrict__ src, int Nsrc, int K, bf16_t* __restrict__ dst, int ndst, int mode,
                                        const float* __restrict__ gain, const float* __restrict__ up_f, const float* __restrict__ up_b, int bi, int nb) {
    const int lane = threadIdx.x & 63, gw = bi * 8 + (threadIdx.x >> 6), nw = nb * 8;
    const int nT = ndst >> 6, kT = K >> 6, ntile = nT * kT;
    int t0 = (gw - tbase % nw + nw) % nw; tbase += ntile;
    for (int t = t0; t < ntile; t += nw) {
        const int n0 = (t % nT) << 6, k0 = (t / nT) << 6, n = n0 + lane;
        int col = n; float scale = 1.f;
        if (mode == CM_SWIGLU) { const int j = n & 255, pn = n >> 8; col = (j < 128) ? pn * 128 + j : FF + pn * 128 + (j - 128); }
        else if (mode == CM_WIN_A) { scale = (n < 512) ? 0.08838834764831845f : 1.f; }
        else if (mode == CM_WIN_B) { col = 3104 + n; }
        float v[64];
        if (mode == CM_FOLD) {
            const int dirb = n >> 9, c = n & 511; const float* up = dirb ? up_b : up_f;
            float upv[16];
#pragma unroll
            for (int r = 0; r < 16; ++r) upv[r] = up[r * 512 + c];
#pragma unroll
            for (int j = 0; j < 64; ++j) { const float* wp = src + (size_t)(k0 + j) * Nsrc + 3072 + 16 * dirb; float sacc = 0.f;
#pragma unroll
                for (int r = 0; r < 16; ++r) sacc += wp[r] * upv[r];
                v[j] = sacc; }
        } else {
            const float* sp = src + (size_t)k0 * Nsrc + col;
#pragma unroll
            for (int j = 0; j < 64; ++j) v[j] = sp[(size_t)j * Nsrc];
        }
        bf16_t* dp = dst + (size_t)n * K + k0;
        if (gain) {
#pragma unroll
            for (int j8 = 0; j8 < 8; ++j8) { const f32x4 g0 = *(const f32x4*)(gain + k0 + 8 * j8), g1 = *(const f32x4*)(gain + k0 + 8 * j8 + 4);
                u32x4 w; w.x = cvt_pk_bf16(v[8 * j8] * g0[0] * scale, v[8 * j8 + 1] * g0[1] * scale); w.y = cvt_pk_bf16(v[8 * j8 + 2] * g0[2] * scale, v[8 * j8 + 3] * g0[3] * scale);
                w.z = cvt_pk_bf16(v[8 * j8 + 4] * g1[0] * scale, v[8 * j8 + 5] * g1[1] * scale); w.w = cvt_pk_bf16(v[8 * j8 + 6] * g1[2] * scale, v[8 * j8 + 7] * g1[3] * scale);
                *(u32x4*)(dp + 8 * j8) = w; }
        } else {
#pragma unroll
            for (int j8 = 0; j8 < 8; ++j8) { u32x4 w; w.x = cvt_pk_bf16(v[8 * j8], v[8 * j8 + 1]); w.y = cvt_pk_bf16(v[8 * j8 + 2], v[8 * j8 + 3]);
                w.z = cvt_pk_bf16(v[8 * j8 + 4], v[8 * j8 + 5]); w.w = cvt_pk_bf16(v[8 * j8 + 6], v[8 * j8 + 7]); *(u32x4*)(dp + 8 * j8) = w; }
        }
    }
}
__device__ __forceinline__ float sq4(const f32x4 v) { return v[0] * v[0] + v[1] * v[1] + v[2] * v[2] + v[3] * v[3]; }
__device__ __forceinline__ void rows_prenorm(const float* __restrict__ x, bf16_t* __restrict__ XN, float* __restrict__ RN, int bi, int nb, int nrows) {
    const int lane = threadIdx.x & 63, gw = bi * 8 + (threadIdx.x >> 6), nw = nb * 8;
    for (int row = gw; row < nrows; row += 2 * nw) {
        f32x4 v[2][4]; float ss[2] = {0.f, 0.f};
#pragma unroll
        for (int u = 0; u < 2; ++u) { const float* xp = x + (size_t)(row + u * nw) * DM + 4 * lane;
#pragma unroll
            for (int c = 0; c < 4; ++c) v[u][c] = *(const f32x4*)(xp + 256 * c); }
#pragma unroll
        for (int u = 0; u < 2; ++u) {
#pragma unroll
            for (int c = 0; c < 4; ++c) ss[u] += sq4(v[u][c]);
            ss[u] = wave_sum(ss[u]); const float ms = ss[u] * (1.0f / DM) + EPS, ri = rsqrtf(ms);
            if (lane == 0) RN[row + u * nw] = ms * ri;
            bf16_t* op = XN + (size_t)(row + u * nw) * DM + 4 * lane;
#pragma unroll
            for (int c = 0; c < 4; ++c) { u32x2 w; w.x = cvt_pk_bf16(v[u][c][0] * ri, v[u][c][1] * ri); w.y = cvt_pk_bf16(v[u][c][2] * ri, v[u][c][3] * ri); *(u32x2*)(op + 256 * c) = w; } }
    }
}
template <int BASE_BF16  , bool OUT_BF16>
__device__ __forceinline__ void rows_resnorm(const bf16_t* __restrict__ F, const void* base, const float* __restrict__ gain, float coef, void* __restrict__ out, bf16_t* XN, const float* __restrict__ rn, int bi, int nb, int nrows) {
    const int lane = threadIdx.x & 63, gw = bi * 8 + (threadIdx.x >> 6), nw = nb * 8;
    f32x4 g[4];
#pragma unroll
    for (int c = 0; c < 4; ++c) g[c] = *(const f32x4*)(gain + 256 * c + 4 * lane);
    for (int row = gw; row < nrows; row += 2 * nw) {
        f32x4 f[2][4], h[2][4];
#pragma unroll
        for (int u = 0; u < 2; ++u) { const size_t ro = (size_t)(row + u * nw) * DM + 4 * lane;
#pragma unroll
            for (int c = 0; c < 4; ++c) { const u32x2 w = *(const u32x2*)(F + ro + 256 * c); f[u][c] = (f32x4){bf_lo(w.x), bf_hi(w.x), bf_lo(w.y), bf_hi(w.y)};
                if (BASE_BF16) { const u32x2 bw = *(const u32x2*)((const bf16_t*)base + ro + 256 * c); h[u][c] = (f32x4){bf_lo(bw.x), bf_hi(bw.x), bf_lo(bw.y), bf_hi(bw.y)}; if (BASE_BF16 == 2) h[u][c] = h[u][c] * rn[row + u * nw]; }
                else h[u][c] = *(const f32x4*)((const float*)base + ro + 256 * c); } }
#pragma unroll
        for (int u = 0; u < 2; ++u) { const size_t ro = (size_t)(row + u * nw) * DM + 4 * lane; float ss = 0.f;
#pragma unroll
            for (int c = 0; c < 4; ++c) ss += sq4(f[u][c]);
            ss = wave_sum(ss); const float ri = rsqrtf(ss * (1.0f / DM) + EPS) * coef; float s2 = 0.f;
#pragma unroll
            for (int c = 0; c < 4; ++c) { h[u][c] += f[u][c] * g[c] * ri; s2 += sq4(h[u][c]);
                if (OUT_BF16) { u32x2 w; w.x = cvt_pk_bf16(h[u][c][0], h[u][c][1]); w.y = cvt_pk_bf16(h[u][c][2], h[u][c][3]); *(u32x2*)((bf16_t*)out + ro + 256 * c) = w; }
                else *(f32x4*)((float*)out + ro + 256 * c) = h[u][c]; }
            if (XN) { s2 = wave_sum(s2); const float r2 = rsqrtf(s2 * (1.0f / DM) + EPS);
#pragma unroll
                for (int c = 0; c < 4; ++c) { u32x2 w; w.x = cvt_pk_bf16(h[u][c][0] * r2, h[u][c][1] * r2); w.y = cvt_pk_bf16(h[u][c][2] * r2, h[u][c][3] * r2); *(u32x2*)(XN + ro + 256 * c) = w; } } }
    }
}
__device__ __forceinline__ void rows_gla_merge(bf16_t* OF, const bf16_t* __restrict__ OB, const bf16_t* __restrict__ Z1, const float* __restrict__ og, int bi, int nb, int nrows) {
    const int lane = threadIdx.x & 63, gw = bi * 8 + (threadIdx.x >> 6), nw = nb * 8;
    f32x4 g[4];
#pragma unroll
    for (int c = 0; c < 4; ++c) g[c] = *(const f32x4*)(og + 256 * c + 4 * lane);
    for (int row = gw; row < nrows; row += 2 * nw) {
        u32x2 ra[2][4], rb[2][4], rr_[2][4];
#pragma unroll
        for (int u = 0; u < 2; ++u) { const size_t ro = (size_t)(row + u * nw) * DM + 4 * lane; const bf16_t* zr = Z1 + (size_t)(row + u * nw) * NZ1 + 2048 + 4 * lane;
#pragma unroll
            for (int c = 0; c < 4; ++c) { ra[u][c] = *(const u32x2*)(OF + ro + 256 * c); rb[u][c] = *(const u32x2*)(OB + ro + 256 * c); rr_[u][c] = *(const u32x2*)(zr + 256 * c); } }
#pragma unroll
        for (int u = 0; u < 2; ++u) { const size_t ro = (size_t)(row + u * nw) * DM + 4 * lane;
#pragma unroll
            for (int c = 0; c < 4; ++c) { const u32x2 a = ra[u][c], b = rb[u][c], r = rr_[u][c];
                f32x4 o = (f32x4){bf_lo(a.x) + bf_lo(b.x), bf_hi(a.x) + bf_hi(b.x), bf_lo(a.y) + bf_lo(b.y), bf_hi(a.y) + bf_hi(b.y)};
                float ss = wave_sum(o[0] * o[0] + o[1] * o[1] + o[2] * o[2] + o[3] * o[3]); const float ri = rsqrtf(ss * (1.0f / 256.0f) + EPS);
                const f32x4 rr = (f32x4){bf_lo(r.x), bf_hi(r.x), bf_lo(r.y), bf_hi(r.y)}; o = o * g[c] * rr * ri;
                u32x2 w; w.x = cvt_pk_bf16(o[0], o[1]); w.y = cvt_pk_bf16(o[2], o[3]); *(u32x2*)(OF + ro + 256 * c) = w; } }
    }
}
__device__ __forceinline__ void rows_rope(bf16_t* Z2, const float* __restrict__ qg, const float* __restrict__ kg, int bi, int nb, int nrows) {
    const int lane = threadIdx.x & 63, gw = bi * 8 + (threadIdx.x >> 6), nw = nb * 8;
    const int e0 = 2 * lane, jf = e0 & 31;
    const float if0 = exp2f(-(float)jf * (13.287712379549449f / 32.0f)), if1 = exp2f(-(float)(jf + 1) * (13.287712379549449f / 32.0f));
    const float gq0 = qg[e0], gq1 = qg[e0 + 1], gk0 = kg[e0], gk1 = kg[e0 + 1];
    const bool second = (e0 & 32) != 0;
    for (int tok = gw; tok < nrows; tok += 4 * nw) {
        unsigned xr[4][10];
#pragma unroll
        for (int u = 0; u < 4; ++u) { const unsigned* bp = (const unsigned*)(Z2 + (size_t)(tok + u * nw) * NZ2) + lane;
#pragma unroll
            for (int hh = 8; hh < 10; ++hh) xr[u][hh] = bp[hh * 64]; }
#pragma unroll
        for (int u = 0; u < 4; ++u) { const int t = tok + u * nw, pos = t & (SEQ - 1);
            const float p = (float)((lane < 32) ? (pos >> 6) : (pos & 63));
            float s0, c0, s1, c1; sincosf(p * if0, &s0, &c0); sincosf(p * if1, &s1, &c1);
            if (!second) { s0 = -s0; s1 = -s1; }
            unsigned* op = (unsigned*)(Z2 + (size_t)t * NZ2) + lane;
#pragma unroll
            for (int hh = 8; hh < 10; ++hh) { const float x0 = bf_lo(xr[u][hh]), x1 = bf_hi(xr[u][hh]);
                const float ss = wave_sum(x0 * x0 + x1 * x1), ri = rsqrtf(ss * (1.0f / 128.0f) + EPS);
                const float y0 = x0 * ri * (hh < 8 ? gq0 : gk0), y1 = x1 * ri * (hh < 8 ? gq1 : gk1);
                const float z0 = __shfl_xor(y0, 16), z1 = __shfl_xor(y1, 16);
                op[hh * 64] = cvt_pk_bf16(y0 * c0 + z0 * s0, y1 * c1 + z1 * s1); }
        }
    }
}
__device__ __forceinline__ void gla_phase(unsigned char* lds, const bf16_t* __restrict__ Z1, bf16_t* __restrict__ Of, bf16_t* __restrict__ Ob, int bi, int nb, int nitems) {
    int tid_ = threadIdx.x; asm volatile("" : "+v"(tid_));
    const int tid = tid_, lane = tid & 63, w = tid >> 6, r = lane & 15, q = lane >> 4;
    constexpr int QS_B = 64 * 136 * 2, KD_B = 128 * 72 * 2, VT_B = 128 * 72 * 2, PP_B = 64 * 72 * 2, DEC_B = 512, BUF_B = QS_B + KD_B + VT_B + PP_B + DEC_B;
    bf16_t* KS = (bf16_t*)(lds + 2 * BUF_B);
    float* SEG = (float*)(lds + 2 * BUF_B + QS_B);
    const int d2 = lane * 2;
#define GLA_WAIT() do { asm volatile("s_waitcnt lgkmcnt(0)" ::: "memory"); __builtin_amdgcn_sched_barrier(0); } while (0)
    for (int it0 = bi; it0 < nitems; it0 += nb) {
        const int item = (nitems == 128 && nb == 128) ? ((it0 & 7) * 16 + (it0 >> 3)) : it0;
        const int dir = item & 1, dvs = (item >> 1) & 1, h = (item >> 2) & 3, b = item >> 4;
        const bf16_t* zq = Z1 + (size_t)(b * SEQ + 8 * w) * NZ1 + h * 128 + d2;
        const bf16_t* zk = zq + 512;
        const bf16_t* zv = Z1 + (size_t)(b * SEQ + 8 * w) * NZ1 + 1024 + h * 256 + dvs * 128 + d2;
        const bf16_t* zg = zq + 3072 + dir * 512;
        bf16_t* og = (dir ? Ob : Of) + (size_t)(b * SEQ) * DM + h * 256 + dvs * 128 + 16 * w + r;
        f32x4 S[8];
#pragma unroll
        for (int mb = 0; mb < 8; ++mb) S[mb] = (f32x4){0.f, 0.f, 0.f, 0.f};
        unsigned rq[8], rk[8], rg[8], rv[8];
        { const size_t co = (size_t)((dir ? 31 : 0) * 64) * NZ1;
#pragma unroll
          for (int tt = 0; tt < 8; ++tt) { const size_t o = co + (size_t)tt * NZ1; rq[tt] = *(const unsigned*)(zq + o); rk[tt] = *(const unsigned*)(zk + o); rg[tt] = *(const unsigned*)(zg + o); rv[tt] = *(const unsigned*)(zv + o); } }
        float ga[8], gb[8];
        for (int step = -1; step < 32; ++step) {
            const int c = dir ? 31 - step : step;
            const int cnn = dir ? c - 2 : c + 2;
            const bool prod = step + 1 < 32, cons = step >= 0, pref = step + 2 < 32;
            unsigned char* bx = lds + (step & 1) * BUF_B;
            unsigned char* by = lds + ((step + 1) & 1) * BUF_B;
            bf16_t* QSx = (bf16_t*)bx; bf16_t* KDx = (bf16_t*)(bx + QS_B); bf16_t* VTx = (bf16_t*)(bx + QS_B + KD_B); bf16_t* PPx = (bf16_t*)(bx + QS_B + KD_B + VT_B); float* DECx = (float*)(bx + QS_B + KD_B + VT_B + PP_B);
            bf16_t* QSy = (bf16_t*)by; bf16_t* KDy = (bf16_t*)(by + QS_B); bf16_t* VTy = (bf16_t*)(by + QS_B + KD_B); bf16_t* PPy = (bf16_t*)(by + QS_B + KD_B + VT_B); float* DECy = (float*)(by + QS_B + KD_B + VT_B + PP_B);
            f32x4 O[4];
            O[0] = (f32x4){0.f, 0.f, 0.f, 0.f}; O[1] = O[0]; O[2] = O[0]; O[3] = O[0];
            if (cons) {
                bf16x8 sbf[4];
#pragma unroll
                for (int kk = 0; kk < 4; ++kk) { u32x4 t; t.x = cvt_pk_bf16(S[2 * kk][0], S[2 * kk][1]); t.y = cvt_pk_bf16(S[2 * kk][2], S[2 * kk][3]); t.z = cvt_pk_bf16(S[2 * kk + 1][0], S[2 * kk + 1][1]); t.w = cvt_pk_bf16(S[2 * kk + 1][2], S[2 * kk + 1][3]); sbf[kk] = *reinterpret_cast<bf16x8*>(&t); }
#pragma unroll
                for (int tp = 0; tp < 2; ++tp) { u32x4 af[2][4];
#pragma unroll
                    for (int t2 = 0; t2 < 2; ++t2)
#pragma unroll
                        for (int kk = 0; kk < 4; ++kk) { const bf16_t* ap = QSx + (16 * (2 * tp + t2) + r) * 136 + 32 * kk + 4 * q; const u32x2 lo = *(const u32x2*)ap, hi = *(const u32x2*)(ap + 16); af[t2][kk] = (u32x4){lo.x, lo.y, hi.x, hi.y}; }
                    GLA_WAIT();
#pragma unroll
                    for (int t2 = 0; t2 < 2; ++t2)
#pragma unroll
                        for (int kk = 0; kk < 4; ++kk) O[2 * tp + t2] = __builtin_amdgcn_mfma_f32_16x16x32_bf16(*reinterpret_cast<bf16x8*>(&af[t2][kk]), sbf[kk], O[2 * tp + t2], 0, 0, 0);
                    __builtin_amdgcn_sched_barrier(0); }
            }
            if (prod) {
#pragma unroll
                for (int tt = 0; tt < 8; ++tt) { ga[tt] = bf_lo(rg[tt]); gb[tt] = bf_hi(rg[tt]); }
                if (!dir) {
#pragma unroll
                    for (int tt = 1; tt < 8; ++tt) { ga[tt] += ga[tt - 1]; gb[tt] += gb[tt - 1]; }
                    *(float2*)(SEG + w * 128 + d2) = make_float2(ga[7], gb[7]);
                } else {
#pragma unroll
                    for (int tt = 6; tt >= 0; --tt) { ga[tt] += ga[tt + 1]; gb[tt] += gb[tt + 1]; }
                    *(float2*)(SEG + w * 128 + d2) = make_float2(ga[0], gb[0]);
                }
                { u32x4 va, vb;
                  va.x = (rv[0] & 0xffffu) | (rv[1] << 16); va.y = (rv[2] & 0xffffu) | (rv[3] << 16); va.z = (rv[4] & 0xffffu) | (rv[5] << 16); va.w = (rv[6] & 0xffffu) | (rv[7] << 16);
                  vb.x = (rv[0] >> 16) | (rv[1] & 0xffff0000u); vb.y = (rv[2] >> 16) | (rv[3] & 0xffff0000u); vb.z = (rv[4] >> 16) | (rv[5] & 0xffff0000u); vb.w = (rv[6] >> 16) | (rv[7] & 0xffff0000u);
                  *(u32x4*)(VTy + d2 * 72 + 8 * w) = va; *(u32x4*)(VTy + (d2 + 1) * 72 + 8 * w) = vb; }
                if (pref) { const size_t co = (size_t)(cnn * 64) * NZ1;
#pragma unroll
                    for (int tt = 0; tt < 8; ++tt) { const size_t o = co + (size_t)tt * NZ1; rg[tt] = *(const unsigned*)(zg + o); rv[tt] = *(const unsigned*)(zv + o); } }
            }
            LBAR();
            if (cons) {
                const bf16x8 v0 = *(const bf16x8*)(VTx + (16 * w + r) * 72 + 8 * q), v1 = *(const bf16x8*)(VTx + (16 * w + r) * 72 + 32 + 8 * q);
#pragma unroll
                for (int hb = 0; hb < 2; ++hb) { bf16x8 kd0[4], kd1[4]; f32x4 dc[4];
#pragma unroll
                    for (int m4 = 0; m4 < 4; ++m4) { const int mb = 4 * hb + m4; dc[m4] = *(const f32x4*)(DECx + 16 * mb + 4 * q);
                        kd0[m4] = *(const bf16x8*)(KDx + (16 * mb + r) * 72 + 8 * q); kd1[m4] = *(const bf16x8*)(KDx + (16 * mb + r) * 72 + 32 + 8 * q); }
                    GLA_WAIT();
#pragma unroll
                    for (int m4 = 0; m4 < 4; ++m4) { const int mb = 4 * hb + m4; S[mb] = S[mb] * dc[m4];
                        S[mb] = __builtin_amdgcn_mfma_f32_16x16x32_bf16(kd0[m4], v0, S[mb], 0, 0, 0); S[mb] = __builtin_amdgcn_mfma_f32_16x16x32_bf16(kd1[m4], v1, S[mb], 0, 0, 0); }
                    __builtin_amdgcn_sched_barrier(0); }
            }
            if (prod) {
                float offa = 0.f, offb = 0.f, tota = 0.f, totb = 0.f;
#pragma unroll
                for (int s = 0; s < 8; ++s) { const float2 v = *(const float2*)(SEG + s * 128 + d2); tota += v.x; totb += v.y; const bool inc = dir ? (s > w) : (s < w); offa += inc ? v.x : 0.f; offb += inc ? v.y : 0.f; }
                const float eta = __expf(tota), etb = __expf(totb);
                if (w == 0) *(float2*)(DECy + d2) = make_float2(eta, etb);
                float kda[8], kdb[8];
#pragma unroll
                for (int tt = 0; tt < 8; ++tt) { const float ba = offa + ga[tt], bb = offb + gb[tt];
                    const float ea = __expf(ba), eb = __expf(bb), iea = __expf(-ba), ieb = __expf(-bb);
                    const float ksa = bf_lo(rk[tt]) * iea, ksb = bf_hi(rk[tt]) * ieb;
                    *(unsigned*)(QSy + (8 * w + tt) * 136 + d2) = cvt_pk_bf16(bf_lo(rq[tt]) * ea, bf_hi(rq[tt]) * eb);
                    *(unsigned*)(KS + (8 * w + tt) * 136 + d2) = cvt_pk_bf16(ksa, ksb);
                    kda[tt] = ksa * eta; kdb[tt] = ksb * etb; }
                u32x4 ka, kb;
                ka.x = cvt_pk_bf16(kda[0], kda[1]); ka.y = cvt_pk_bf16(kda[2], kda[3]); ka.z = cvt_pk_bf16(kda[4], kda[5]); ka.w = cvt_pk_bf16(kda[6], kda[7]);
                kb.x = cvt_pk_bf16(kdb[0], kdb[1]); kb.y = cvt_pk_bf16(kdb[2], kdb[3]); kb.z = cvt_pk_bf16(kdb[4], kdb[5]); kb.w = cvt_pk_bf16(kdb[6], kdb[7]);
                *(u32x4*)(KDy + d2 * 72 + 8 * w) = ka; *(u32x4*)(KDy + (d2 + 1) * 72 + 8 * w) = kb;
                if (pref) { const size_t co = (size_t)(cnn * 64) * NZ1;
#pragma unroll
                    for (int tt = 0; tt < 8; ++tt) { const size_t o = co + (size_t)tt * NZ1; rq[tt] = *(const unsigned*)(zq + o); rk[tt] = *(const unsigned*)(zk + o); } }
            }
            LBAR();
            if (cons) {
                bf16x8 pp0[4], pp1[4];
                const bf16x8 v0 = *(const bf16x8*)(VTx + (16 * w + r) * 72 + 8 * q), v1 = *(const bf16x8*)(VTx + (16 * w + r) * 72 + 32 + 8 * q);
#pragma unroll
                for (int tb = 0; tb < 4; ++tb) { pp0[tb] = *(const bf16x8*)(PPx + (16 * tb + r) * 72 + 8 * q); pp1[tb] = *(const bf16x8*)(PPx + (16 * tb + r) * 72 + 32 + 8 * q); }
                GLA_WAIT();
#pragma unroll
                for (int tb = 0; tb < 4; ++tb) { O[tb] = __builtin_amdgcn_mfma_f32_16x16x32_bf16(pp0[tb], v0, O[tb], 0, 0, 0); O[tb] = __builtin_amdgcn_mfma_f32_16x16x32_bf16(pp1[tb], v1, O[tb], 0, 0, 0); }
                bf16_t* op = og + (size_t)(c * 64) * DM;
#pragma unroll
                for (int tb = 0; tb < 4; ++tb)
#pragma unroll
                    for (int i = 0; i < 4; ++i) op[(size_t)(16 * tb + 4 * q + i) * DM] = attn::f2bf_rne(O[tb][i]);
            }
            if (prod) {
                const int tb = w >> 1; f32x4 p0 = (f32x4){0.f, 0.f, 0.f, 0.f}, p1 = p0;
                bf16x8 pa[4], pb0[4], pb1[4];
#pragma unroll
                for (int kk = 0; kk < 4; ++kk) { pa[kk] = *(const bf16x8*)(QSy + (16 * tb + r) * 136 + 32 * kk + 8 * q);
                    pb0[kk] = *(const bf16x8*)(KS + (32 * (w & 1) + r) * 136 + 32 * kk + 8 * q); pb1[kk] = *(const bf16x8*)(KS + (32 * (w & 1) + 16 + r) * 136 + 32 * kk + 8 * q); }
                GLA_WAIT();
#pragma unroll
                for (int kk = 0; kk < 4; ++kk) { p0 = __builtin_amdgcn_mfma_f32_16x16x32_bf16(pa[kk], pb0[kk], p0, 0, 0, 0); p1 = __builtin_amdgcn_mfma_f32_16x16x32_bf16(pa[kk], pb1[kk], p1, 0, 0, 0); }
                const int j0 = 32 * (w & 1) + r, j1 = j0 + 16;
#pragma unroll
                for (int i = 0; i < 4; ++i) { const int it = 16 * tb + 4 * q + i;
                    const bool k0 = dir ? (j0 > it) : (j0 <= it), k1 = dir ? (j1 > it) : (j1 <= it);
                    PPy[it * 72 + j0] = attn::f2bf_rne(k0 ? p0[i] : 0.f); PPy[it * 72 + j1] = attn::f2bf_rne(k1 ? p1[i] : 0.f); }
            }
            LBAR();
        }
    }
#undef GLA_WAIT
}

__device__ __forceinline__ void attn_phase(unsigned char* lds, const bf16_t* Z2, bf16_t* OA, const float* __restrict__ qg, int bi, int nb, int nunits) {
    for (int u0 = bi, i_ = 0; u0 < nunits; u0 += nb, ++i_) {
        int u = u0;
        if (nunits == 512 && nb == 128) { const int x = bi & 7, t = i_ * 16 + (bi >> 3), bk = x * 2 + (t >> 5);
            u = ((bk >> 1) << 6) | ((((bk & 1) << 2) | ((t >> 3) & 3)) << 3) | (t & 7); }
        const int qb = u & 7, hq = (u >> 3) & 7, b = u >> 6, kvh = hq >> 2;
        const size_t row0 = (size_t)b * SEQ;
        const attn::bf16* Qb = (const attn::bf16*)(Z2 + (row0 + qb * 256) * NZ2 + hq * 128);
        const attn::bf16* Kh = (const attn::bf16*)(Z2 + row0 * NZ2 + 1024 + kvh * 128);
        const attn::bf16* Vh = (const attn::bf16*)(Z2 + row0 * NZ2 + 1280 + kvh * 128);
        attn::attn_dense_body<attn::bf16>(Qb, Kh, Vh, OA + (row0 + qb * 256) * DM + hq * 128, SEQ, (char*)lds, qg, qb * 256);
        __syncthreads();
    }
}

constexpr int NPHASE = 17;
struct Args { const float* in[22]; float* out; unsigned char* ws; int ph_lo, ph_hi; };

__global__ void __launch_bounds__(512, 2) mk_fwd(Args a) {
    extern __shared__ __attribute__((aligned(16))) unsigned char lds[];
    cg::grid_group grid = cg::this_grid();
    PG8_LAS unsigned char* llds = (PG8_LAS unsigned char*)lds;
    unsigned char* ws = a.ws;
    bf16_t* W1IN = (bf16_t*)(ws + WS_W1IN); bf16_t* W1OUT = (bf16_t*)(ws + WS_W1OUT); bf16_t* WIN = (bf16_t*)(ws + WS_WIN);
    bf16_t* WA = (bf16_t*)(ws + WS_WA); bf16_t* WB = (bf16_t*)(ws + WS_WB); bf16_t* WO = (bf16_t*)(ws + WS_WO);
    bf16_t* W2IN = (bf16_t*)(ws + WS_W2IN); bf16_t* W2OUT = (bf16_t*)(ws + WS_W2OUT);
    const int G = gridDim.x, bx = blockIdx.x, GG = G >> 1;
    constexpr int TG = T / 2;
#define GV() int bxo_ = blockIdx.x; asm volatile("" : "+s"(bxo_)); const int grp = (bxo_ >> 3) & 1, gi = (bxo_ & 7) | ((bxo_ >> 4) << 3); const size_t R0 = (size_t)grp * TG; \
    bf16_t* XN = (bf16_t*)(ws + WS_XN) + R0 * DM; bf16_t* FB = (bf16_t*)(ws + WS_F) + R0 * DM; bf16_t* OG = (bf16_t*)(ws + WS_OG) + R0 * DM; \
    bf16_t* ZB = (bf16_t*)(ws + WS_Z + (size_t)grp * (128 * MiB)); bf16_t* HP = (bf16_t*)(a.out + R0 * DM); float* OUTF = a.out + R0 * DM; float* RN = (float*)(ws + WS_RN) + R0; \
    (void)gi; (void)XN; (void)FB; (void)OG; (void)ZB; (void)HP; (void)OUTF; (void)RN
    volatile LAS unsigned* xst = (volatile LAS unsigned*)(llds + (LDS_BYTES - 16));
    if (threadIdx.x < 4) xst[threadIdx.x] = 0u;
    __syncthreads();
    { GV(); (void)xcd_barrier_post((unsigned*)(ws + WS_CTL), xst); (void)xcd_barrier_post((unsigned*)(ws + WS_CTL) + (1 + grp) * 4096, xst + 2); }
    if (a.ph_lo < 0) grid.sync();
#define BAR_ALL() do { XcdBarrier xb_; xb_.bar = (unsigned*)(ws + WS_CTL); xb_.x = xb_xcc_id(); xb_.gsz = (unsigned)G; xb_.st = xst; xcd_barrier(xb_); } while (0)
#define SEAM() do { XcdBarrier xb_; xb_.bar = (unsigned*)(ws + WS_CTL) + (1 + ((blockIdx.x >> 3) & 1)) * 4096; xb_.x = xb_xcc_id(); xb_.gsz = (unsigned)GG; xb_.st = xst + 2; xcd_barrier(xb_); } while (0)
    using namespace pg8;
    { int tl = 0;
      cvt_job(tl, a.in[2], 2 * FF, DM, W1IN, 2 * FF, CM_SWIGLU, a.in[1], nullptr, nullptr, bx, G);
      rows_prenorm(a.in[0], (bf16_t*)(ws + WS_XN), (float*)(ws + WS_RN), bx, G, T); }
    BAR_ALL();
    if (((blockIdx.x >> 3) & 1) == 1) { GV(); int tl = 0;
      cvt_job(tl, a.in[3], DM, FF, W1OUT, DM, CM_ID, nullptr, nullptr, nullptr, gi, GG);
      cvt_job(tl, a.in[6], NWIN, DM, WIN, 3072, CM_WIN_A, a.in[5], nullptr, nullptr, gi, GG);
      cvt_job(tl, a.in[6], NWIN, DM, WIN + (size_t)3072 * DM, 1024, CM_FOLD, a.in[5], a.in[7], a.in[9], gi, GG);
      cvt_job(tl, a.in[6], NWIN, DM, WIN + (size_t)4096 * DM, NZ2, CM_WIN_B, a.in[5], nullptr, nullptr, gi, GG);
      cvt_job(tl, a.in[12], DM, DM, WA, DM, CM_ID, nullptr, nullptr, nullptr, gi, GG);
      cvt_job(tl, a.in[15], DM, DM, WB, DM, CM_ID, nullptr, nullptr, nullptr, gi, GG);
      cvt_job(tl, a.in[16], DM, DM, WO, DM, CM_ID, nullptr, nullptr, nullptr, gi, GG);
      cvt_job(tl, a.in[19], 2 * FF, DM, W2IN, 2 * FF, CM_SWIGLU, a.in[18], nullptr, nullptr, gi, GG);
      cvt_job(tl, a.in[20], DM, FF, W2OUT, DM, CM_ID, nullptr, nullptr, nullptr, gi, GG);
      SEAM();
      if (threadIdx.x == 0) __hip_atomic_fetch_add((unsigned*)(ws + WS_CTL) + 3 * 4096, 1u, __ATOMIC_RELAXED, __HIP_MEMORY_SCOPE_AGENT);
    }
    { GV(); Gemm g{XN, W1IN, TG, 2 * FF, DM}; StaticOrder S; S.init(TG, 2 * FF, GG, gi); EpiSwiglu E{ZB, FF}; gemm_phase<EpiSwiglu, StaticOrder>(llds, g, S, E); }
    SEAM();
    if (((blockIdx.x >> 3) & 1) == 0) {
        if (threadIdx.x == 0) { unsigned sp = 0; while (__hip_atomic_load((unsigned*)(ws + WS_CTL) + 3 * 4096, __ATOMIC_RELAXED, __HIP_MEMORY_SCOPE_AGENT) < (unsigned)GG && ++sp < (1u << 22)) __builtin_amdgcn_s_sleep(2);
            __builtin_amdgcn_fence(__ATOMIC_ACQUIRE, "agent"); asm volatile("s_waitcnt vmcnt(0)" ::: "memory"); }
        __syncthreads();
    }
    { GV(); Gemm g{ZB, W1OUT, TG, DM, FF}; StaticOrder S; S.init(TG, DM, GG, gi); EpiAct E{FB, DM, 0, nullptr, nullptr}; gemm_phase<EpiAct, StaticOrder>(llds, g, S, E); }
    SEAM();
    { GV(); rows_resnorm<2, true>(FB, XN, a.in[4], 0.5f, HP, XN, RN, gi, GG, TG); }
    SEAM();
    { GV(); Gemm g{XN, WIN, TG, NZ1, DM}; StaticOrder S; S.init(TG, NZ1, GG, gi); EpiAct E{ZB, NZ1, 1, a.in[8], a.in[10]}; gemm_phase<EpiAct, StaticOrder>(llds, g, S, E); }
    SEAM();
    { GV(); gla_phase(lds, ZB, OG, FB, gi, GG, 128); }
    SEAM();
    { GV(); rows_gla_merge(OG, FB, ZB, a.in[11], gi, GG, TG); }
    SEAM();
    { GV(); Gemm g{XN, WIN + (size_t)4096 * DM, TG, NZ2, DM}; StaticOrder S; S.init(TG, NZ2, GG, gi); EpiAct E{ZB, NZ2, 2, nullptr, nullptr}; gemm_phase<EpiAct, StaticOrder>(llds, g, S, E); }
    SEAM();
    { GV(); Gemm g{OG, WA, TG, DM, DM}; StaticOrder S; S.init(TG, DM, GG, gi); EpiGate<false> E{FB, DM, ZB + 1536, NZ2}; gemm_phase<EpiGate<false>, StaticOrder>(llds, g, S, E); }
    { GV(); rows_rope(ZB, a.in[13], a.in[14], gi, GG, TG); }
    SEAM();
    { GV(); attn_phase(lds, ZB, XN, a.in[13], gi, GG, 512); }
    SEAM();
    { GV(); Gemm g{XN, WB, TG, DM, DM}; StaticOrder S; S.init(TG, DM, GG, gi); EpiGate<true> E{FB, DM, ZB + 2560, NZ2}; gemm_phase<EpiGate<true>, StaticOrder>(llds, g, S, E); }
    SEAM();
    { GV(); Gemm g{FB, WO, TG, DM, DM}; StaticOrder S; S.init(TG, DM, GG, gi); EpiAct E{ZB, DM, 0, nullptr, nullptr}; gemm_phase<EpiAct, StaticOrder>(llds, g, S, E); }
    SEAM();
    { GV(); rows_resnorm<1, true>(ZB, HP, a.in[17], 1.0f, OG, XN, nullptr, gi, GG, TG); }
    SEAM();
    { GV(); Gemm g{XN, W2IN, TG, 2 * FF, DM}; StaticOrder S; S.init(TG, 2 * FF, GG, gi); EpiSwiglu E{ZB, FF}; gemm_phase<EpiSwiglu, StaticOrder>(llds, g, S, E); }
    SEAM();
    { GV(); Gemm g{ZB, W2OUT, TG, DM, FF}; StaticOrder S; S.init(TG, DM, GG, gi); EpiAct E{FB, DM, 0, nullptr, nullptr}; gemm_phase<EpiAct, StaticOrder>(llds, g, S, E); }
    SEAM();
    if (((blockIdx.x >> 3) & 1) == 1) {
        if (threadIdx.x == 0) __hip_atomic_fetch_add((unsigned*)(ws + WS_CTL) + 3 * 4096 + 64, 1u, __ATOMIC_RELAXED, __HIP_MEMORY_SCOPE_AGENT);
        { GV(); rows_resnorm<1, false>(FB, OG, a.in[21], 0.5f, OUTF, nullptr, nullptr, (int)blockIdx.x, G, TG); }
    } else {
        { GV(); rows_resnorm<1, false>(FB, OG, a.in[21], 0.5f, OUTF, nullptr, nullptr, gi, GG, TG); }
        if (threadIdx.x == 0) { unsigned sp = 0; while (__hip_atomic_load((unsigned*)(ws + WS_CTL) + 3 * 4096 + 64, __ATOMIC_RELAXED, __HIP_MEMORY_SCOPE_AGENT) < (unsigned)GG && ++sp < (1u << 22)) __builtin_amdgcn_s_sleep(2);
            __builtin_amdgcn_fence(__ATOMIC_ACQUIRE, "agent"); asm volatile("s_waitcnt vmcnt(0)" ::: "memory"); }
        __syncthreads();
        { const size_t R1_ = (size_t)TG * DM;
          rows_resnorm<1, false>((bf16_t*)(ws + WS_F) + R1_, (bf16_t*)(ws + WS_OG) + R1_, a.in[21], 0.5f, a.out + R1_, nullptr, nullptr, (int)blockIdx.x, G, TG); }
    }
#undef BAR_ALL
#undef GV
#undef SEAM
}
}

extern "C" void kernel_launch(void* const* d_in, const int* in_sizes, int n_in, void* d_out, int out_size, void* d_ws, size_t ws_size, hipStream_t stream) {
    static int grid = 0;
    if (grid == 0) {
        if (n_in != 22 || in_sizes[0] != mk::T * mk::DM || out_size != mk::T * mk::DM || ws_size < mk::WS_END) {
            fprintf(stderr, "kernel_launch: built for 22 inputs, x/out of %d floats, >= %zu bytes of workspace; got n_in %d in0 %d out %d ws %zu\n", mk::T * mk::DM, (size_t)mk::WS_END, n_in, n_in > 0 ? in_sizes[0] : -1, out_size, ws_size);
            grid = -1; return; }
        int dev = 0, cus = 0, per_cu = 0;
        hipGetDevice(&dev); hipDeviceGetAttribute(&cus, hipDeviceAttributeMultiprocessorCount, dev);
        if (hipFuncSetAttribute((const void*)mk::mk_fwd, hipFuncAttributeMaxDynamicSharedMemorySize, mk::LDS_BYTES) != hipSuccess) { fprintf(stderr, "kernel_launch: hipFuncSetAttribute failed\n"); grid = -1; return; }
        if (hipOccupancyMaxActiveBlocksPerMultiprocessor(&per_cu, (const void*)mk::mk_fwd, 512, mk::LDS_BYTES) != hipSuccess || per_cu < 1) { fprintf(stderr, "kernel_launch: occupancy query says %d blocks per CU\n", per_cu); per_cu = 1; }
        (void)hipGetLastError();
        grid = cus;
        if (grid != 256) { fprintf(stderr, "kernel_launch: this build needs exactly 256 CUs (got %d)\n", grid); grid = -1; return; }
        fprintf(stderr, "kernel_launch: cus %d per_cu %d grid %d ws %zu\n", cus, per_cu, grid, ws_size);
    }
    if (grid < 0) return;
    mk::Args a{};
    for (int i = 0; i < 22; ++i) a.in[i] = (const float*)d_in[i];
    a.out = (float*)d_out; a.ws = (unsigned char*)d_ws;
    if (hipMemsetAsync((char*)d_ws + mk::WS_CTL, 0, 65536, stream) != hipSuccess) { fprintf(stderr, "kernel_launch: hipMemsetAsync failed\n"); return; }
#if MK_PER_PHASE
    for (int p = 0; p < mk::NPHASE; ++p) { a.ph_lo = p; a.ph_hi = p + 1; hipLaunchKernelGGL(mk::mk_fwd, dim3(grid), dim3(512), mk::LDS_BYTES, stream, a); }
#else
    a.ph_lo = 0; a.ph_hi = mk::NPHASE;
    void* args[] = {&a};
    hipError_t e = hipLaunchCooperativeKernel((const void*)mk::mk_fwd, dim3(grid), dim3(512), args, mk::LDS_BYTES, stream);
    if (e != hipSuccess) fprintf(stderr, "kernel_launch: cooperative launch failed: %s (grid %d)\n", hipGetErrorString(e), grid);
#endif
}
```

```cpp
#include <hip/hip_runtime.h>
#include <hip/hip_bf16.h>
#include <hip/hip_cooperative_groups.h>
#include <cstdio>
#include <cstdint>
namespace cg = cooperative_groups;

#ifndef MK_PER_PHASE
#define MK_PER_PHASE 0
#endif

namespace pg8 {
#define PG8_LAS __attribute__((address_space(3)))
typedef unsigned short bf16_t;
typedef short bf16x8 __attribute__((ext_vector_type(8)));
typedef float f32x4 __attribute__((ext_vector_type(4)));
typedef unsigned u32x4 __attribute__((ext_vector_type(4)));
constexpr int BM = 256, BK = 64, HALF = 128, HTB = HALF * BK * 2  , STAGE_BYTES = 8 * HTB, NXCD = 4, WGM = 8;

__host__ __device__ __forceinline__ int lds_byte(int r, int c) { const int st = (r >> 4) * 2 + (c >> 5), rr = r & 15, cc = c & 31, ob = rr * 64 + cc * 2; return st * 1024 + (ob ^ (((ob >> 9) & 1) << 5)); }
__host__ __device__ __forceinline__ void stage_rc(int b, int& R, int& C) { const int st = b / 1024, sb = b % 1024, swz = sb ^ (((sb >> 9) & 1) << 5); R = (st >> 1) * 16 + swz / 64; C = (st & 1) * 32 + (swz % 64) / 2; }
__host__ __device__ __forceinline__ int perm32(int rho) { const int n = rho >> 4, i = rho & 15; return 8 * (i >> 2) + 4 * n + (i & 3); }

struct Unit { int pm, pn; };
struct Gemm { const bf16_t* A; const bf16_t* Bt; int M, N, K; };

struct StaticOrder {
    int nM, nN, nwg, G, c;
    __host__ __device__ void init(int M, int N, int G_, int c_) { nM = M / BM; nN = N / BM; nwg = nM * nN; G = G_; c = c_; }
    __host__ __device__ bool next(int i, Unit& u) const {
        const long L = (long)i * G + c; if (L >= nwg) return false;
        int wgid = (int)L; { const int q = nwg / NXCD, r = nwg % NXCD, xcd = wgid % NXCD, off = wgid / NXCD; wgid = (xcd < r ? xcd * (q + 1) : r * (q + 1) + (xcd - r) * q) + off; }
        const int nig = WGM * nN, gid = wgid / nig, fm = gid * WGM, gsz = (nM - fm) < WGM ? (nM - fm) : WGM;
        u.pm = fm + ((wgid % nig) % gsz); u.pn = (wgid % nig) / gsz; return true;
    }
    __device__ __forceinline__ void a_ready(const Unit&) const {}
    __device__ __forceinline__ void done(const Unit&) const {}
};
__device__ __forceinline__ unsigned cvt_pk_bf16(float lo, float hi) { unsigned r; asm volatile("v_cvt_pk_bf16_f32 %0, %1, %2" : "=v"(r) : "v"(lo), "v"(hi)); return r; }
typedef float f32x2 __attribute__((ext_vector_type(2)));

__device__ __forceinline__ float fsigmoid(float x) { return __builtin_amdgcn_rcpf(1.0f + __expf(-x)); }
__device__ __forceinline__ float fsilu(float x) { return x * fsigmoid(x); }
__device__ __forceinline__ f32x4 sigmoid4(f32x4 x) {
    f32x4 d;
#pragma unroll
    for (int j = 0; j < 4; ++j) d[j] = 1.0f + __expf(-fmaxf(x[j], -20.0f));
    const float p01 = d[0] * d[1], p23 = d[2] * d[3], r = __builtin_amdgcn_rcpf(p01 * p23), r01 = r * p23, r23 = r * p01;
    return (f32x4){r01 * d[1], r01 * d[0], r23 * d[3], r23 * d[2]};
}
__device__ __forceinline__ float flogsig16(float x) { return (fminf(x, 0.f) - __logf(1.0f + __expf(-fabsf(x)))) * 0.0625f; }
__device__ __forceinline__ float bf_lo(unsigned u) { return __uint_as_float(u << 16); }
__device__ __forceinline__ float bf_hi(unsigned u) { return __uint_as_float(u & 0xffff0000u); }

struct EpiAct {
    static constexpr bool PERM = true, AFTER_DRAIN = false;
    bf16_t* O; int ldc; int mode; const float* bias_f; const float* bias_b;
    __device__ __forceinline__ void operator()(const f32x4 (&acc)[2][2][4][2], const Unit& u, int wr, int wc, int fr, int fq) const {
        int act = 0; const float* bias = nullptr;
        if (mode == 1) { if (u.pn >= 8 && u.pn < 12) act = 1; else if (u.pn >= 12) { act = 3; bias = (u.pn >= 14) ? bias_b + (u.pn - 14) * 256 : bias_f + (u.pn - 12) * 256; } }
        else if (mode == 2) { if (u.pn >= 6) act = 2; }
        const int row0 = u.pm * BM + wr * 64 + fr, col0 = u.pn * BM + wc * 32 + 8 * fq, bcol0 = wc * 32 + 8 * fq;
        f32x4 bv[2][2];
#pragma unroll
        for (int bj = 0; bj < 2; ++bj)
#pragma unroll
            for (int n = 0; n < 2; ++n) bv[bj][n] = bias ? *(const f32x4*)(bias + bcol0 + bj * HALF + 4 * n) : (f32x4){0.f, 0.f, 0.f, 0.f};
#pragma unroll
        for (int ai = 0; ai < 2; ++ai)
#pragma unroll
            for (int m = 0; m < 4; ++m) { bf16_t* rowp = O + (size_t)(row0 + ai * HALF + m * 16) * ldc + col0;
#pragma unroll
                for (int bj = 0; bj < 2; ++bj) { f32x4 v0 = acc[ai][bj][m][0] + bv[bj][0], v1 = acc[ai][bj][m][1] + bv[bj][1];
                    if (act == 1) {
#pragma unroll
                        for (int j = 0; j < 1; ++j) { v0 = v0 * sigmoid4(v0); v1 = v1 * sigmoid4(v1); } }
                    else if (act == 2) {
#pragma unroll
                        for (int j = 0; j < 1; ++j) { v0 = sigmoid4(v0); v1 = sigmoid4(v1); } }
                    else if (act == 3) {
#pragma unroll
                        for (int j = 0; j < 4; ++j) { v0[j] = flogsig16(v0[j]); v1[j] = flogsig16(v1[j]); } }
                    u32x4 w; w.x = cvt_pk_bf16(v0[0], v0[1]); w.y = cvt_pk_bf16(v0[2], v0[3]); w.z = cvt_pk_bf16(v1[0], v1[1]); w.w = cvt_pk_bf16(v1[2], v1[3]);
                    *(u32x4*)(rowp + bj * HALF) = w; } }
    }
};
struct EpiSwiglu {
    static constexpr bool PERM = true, AFTER_DRAIN = false;
    bf16_t* O; int ldc;
    __device__ __forceinline__ void operator()(const f32x4 (&acc)[2][2][4][2], const Unit& u, int wr, int wc, int fr, int fq) const {
        const int row0 = u.pm * BM + wr * 64 + fr, col0 = u.pn * HALF + wc * 32 + 8 * fq;
#pragma unroll
        for (int ai = 0; ai < 2; ++ai)
#pragma unroll
            for (int m = 0; m < 4; ++m) { bf16_t* rowp = O + (size_t)(row0 + ai * HALF + m * 16) * ldc + col0;
                f32x4 v0, v1;
#pragma unroll
                for (int j = 0; j < 1; ++j) { v0 = acc[ai][0][m][0] * sigmoid4(acc[ai][0][m][0]) * acc[ai][1][m][0]; v1 = acc[ai][0][m][1] * sigmoid4(acc[ai][0][m][1]) * acc[ai][1][m][1]; }
                u32x4 w; w.x = cvt_pk_bf16(v0[0], v0[1]); w.y = cvt_pk_bf16(v0[2], v0[3]); w.z = cvt_pk_bf16(v1[0], v1[1]); w.w = cvt_pk_bf16(v1[2], v1[3]);
                *(u32x4*)rowp = w; }
    }
};
template <bool ACCUM> struct EpiGate {
    static constexpr bool PERM = true, AFTER_DRAIN = false;
    bf16_t* O; int ldc; const bf16_t* G; int ldg;
    __device__ __forceinline__ void operator()(const f32x4 (&acc)[2][2][4][2], const Unit& u, int wr, int wc, int fr, int fq) const {
        const int row0 = u.pm * BM + wr * 64 + fr, col0 = u.pn * BM + wc * 32 + 8 * fq;
#pragma unroll
        for (int ai = 0; ai < 2; ++ai)
#pragma unroll
            for (int m = 0; m < 4; ++m) { const size_t r = (size_t)(row0 + ai * HALF + m * 16); bf16_t* rowp = O + r * ldc + col0; const bf16_t* gp = G + r * ldg + col0;
#pragma unroll
                for (int bj = 0; bj < 2; ++bj) { const u32x4 gw = *(const u32x4*)(gp + bj * HALF);
                    f32x4 v0 = acc[ai][bj][m][0], v1 = acc[ai][bj][m][1];
                    v0[0] *= bf_lo(gw.x); v0[1] *= bf_hi(gw.x); v0[2] *= bf_lo(gw.y); v0[3] *= bf_hi(gw.y);
                    v1[0] *= bf_lo(gw.z); v1[1] *= bf_hi(gw.z); v1[2] *= bf_lo(gw.w); v1[3] *= bf_hi(gw.w);
                    if (ACCUM) { const u32x4 pw = *(const u32x4*)(rowp + bj * HALF);
                        v0[0] += bf_lo(pw.x); v0[1] += bf_hi(pw.x); v0[2] += bf_lo(pw.y); v0[3] += bf_hi(pw.y);
                        v1[0] += bf_lo(pw.z); v1[1] += bf_hi(pw.z); v1[2] += bf_lo(pw.w); v1[3] += bf_hi(pw.w); }
                    u32x4 w; w.x = cvt_pk_bf16(v0[0], v0[1]); w.y = cvt_pk_bf16(v0[2], v0[3]); w.z = cvt_pk_bf16(v1[0], v1[1]); w.w = cvt_pk_bf16(v1[2], v1[3]);
                    *(u32x4*)(rowp + bj * HALF) = w; } }
    }
};

template <class Epi, class Sched>
__device__ __forceinline__ void gemm_phase(PG8_LAS unsigned char* lds, const Gemm g, const Sched& S, const Epi& E) {
    int tid_ = threadIdx.x; asm volatile("" : "+v"(tid_));
    const int tid = tid_, wid = __builtin_amdgcn_readfirstlane(tid >> 6), lane = tid & 63, wr = wid >> 2, wc = wid & 3, fr = lane & 15, fq = lane >> 4;
    const int K = g.K, nt = K / BK;
    unsigned voffA[2], voffB[2];
#pragma unroll
    for (int i = 0; i < 2; ++i) { int R, C; stage_rc(tid * 16 + i * 8192, R, C); const int Rb = Epi::PERM ? ((R & ~31) + perm32(R & 31)) : R;
        voffA[i] = (unsigned)(R * K + C) * 2u; voffB[i] = (unsigned)(Rb * K + C) * 2u; }
    const size_t kstep = (size_t)(BK * 2);
    const size_t hstep = (size_t)HALF * K * 2;
    const size_t tstep = 2 * hstep;
    const unsigned ldsw = (unsigned)wid * 1024u;
    const int aoff = lds_byte(wr * 64 + fr, fq * 8), boff = lds_byte(wc * 32 + fr, fq * 8);
#define PG8_SA(b, h) (((b) * 2 + (h)) * HTB)
#define PG8_SB(b, h) ((4 + (b) * 2 + (h)) * HTB)
#define PG8_STAGE(bufoff, gbase, voff) do { _Pragma("unroll") for (int _i = 0; _i < 2; ++_i) \
        __builtin_amdgcn_global_load_lds((const unsigned*)((const char*)(gbase) + (voff)[_i]), (PG8_LAS unsigned*)(lds + (bufoff) + ldsw + _i * 8192), 16, 0, 0); } while (0)
#define PG8_LDA(dst, b, h) do { _Pragma("unroll") for (int m = 0; m < 4; ++m) _Pragma("unroll") for (int k = 0; k < 2; ++k) dst[m][k] = *(const PG8_LAS bf16x8*)(lds + PG8_SA(b, h) + aoff + m * 2048 + k * 1024); } while (0)
#define PG8_LDB(dst, b, h) do { _Pragma("unroll") for (int n = 0; n < 2; ++n) _Pragma("unroll") for (int k = 0; k < 2; ++k) dst[n][k] = *(const PG8_LAS bf16x8*)(lds + PG8_SB(b, h) + boff + n * 2048 + k * 1024); } while (0)
#define PG8_MMA(ai, bj, At, Bt) do { __builtin_amdgcn_s_setprio(1); _Pragma("unroll") for (int m = 0; m < 4; ++m) _Pragma("unroll") for (int n = 0; n < 2; ++n) _Pragma("unroll") for (int k = 0; k < 2; ++k) \
        acc[ai][bj][m][n] = __builtin_amdgcn_mfma_f32_16x16x32_bf16(Bt[n][k], At[m][k], acc[ai][bj][m][n], 0, 0, 0); __builtin_amdgcn_s_setprio(0); } while (0)
#define PG8_WAIT_V(n) asm volatile("s_waitcnt vmcnt(" #n ")" ::: "memory")
#define PG8_WAIT_L(n) asm volatile("s_waitcnt lgkmcnt(" #n ")" ::: "memory")
#define PG8_BAR __builtin_amdgcn_s_barrier()
#define PG8_SCHED __builtin_amdgcn_sched_barrier(0)
    Unit cur, nxt; int ui = 0;
    if (!S.next(0, cur)) return;
    f32x4 acc[2][2][4][2];
#pragma unroll
    for (int a = 0; a < 2; ++a)
#pragma unroll
        for (int b = 0; b < 2; ++b)
#pragma unroll
            for (int m = 0; m < 4; ++m)
#pragma unroll
                for (int n = 0; n < 2; ++n) acc[a][b][m][n] = (f32x4){0.f, 0.f, 0.f, 0.f};
    bf16x8 At[4][2], B0[2][2], B1[2][2];
    const char* cA = (const char*)g.A + (size_t)cur.pm * tstep; const char* cB = (const char*)g.Bt + (size_t)cur.pn * tstep;
    S.a_ready(cur);
    PG8_STAGE(PG8_SB(0, 0), cB, voffB); PG8_STAGE(PG8_SA(0, 0), cA, voffA); PG8_STAGE(PG8_SB(0, 1), cB + hstep, voffB); PG8_STAGE(PG8_SA(0, 1), cA + hstep, voffA);
    if (wr == 1) PG8_BAR;
    PG8_WAIT_V(4); PG8_BAR;
    PG8_STAGE(PG8_SB(1, 0), cB + kstep, voffB); PG8_STAGE(PG8_SA(1, 0), cA + kstep, voffA); PG8_STAGE(PG8_SB(1, 1), cB + hstep + kstep, voffB);
    PG8_WAIT_V(6); PG8_BAR;
    for (;;) {
        const bool has_next = S.next(ui + 1, nxt);
        const char* nA = has_next ? (const char*)g.A + (size_t)nxt.pm * tstep : cA; const char* nB = has_next ? (const char*)g.Bt + (size_t)nxt.pn * tstep : cB;
        for (int t = 0; t < nt; t += 2) {
            const bool last = (t == nt - 2);
            const char* a1 = cA + (size_t)(t + 1) * kstep;
            const char* a2 = last ? nA : cA + (size_t)(t + 2) * kstep; const char* b2 = last ? nB : cB + (size_t)(t + 2) * kstep;
            const char* a3 = a2 + kstep; const char* b3 = b2 + kstep;
            if (last && has_next) S.a_ready(nxt);
            PG8_LDB(B0, 0, 0); PG8_SCHED; PG8_LDA(At, 0, 0); PG8_STAGE(PG8_SA(1, 1), a1 + hstep, voffA);
            PG8_WAIT_L(8); PG8_BAR; PG8_WAIT_L(0); PG8_MMA(0, 0, At, B0); PG8_BAR; PG8_SCHED;
            PG8_LDB(B1, 0, 1); PG8_STAGE(PG8_SB(0, 0), b2, voffB);
            PG8_BAR; PG8_WAIT_L(0); PG8_MMA(0, 1, At, B1); PG8_BAR;
            PG8_LDA(At, 0, 1); PG8_STAGE(PG8_SA(0, 0), a2, voffA);
            PG8_BAR; PG8_WAIT_L(0); PG8_MMA(1, 0, At, B0); PG8_BAR; PG8_SCHED;
            PG8_STAGE(PG8_SB(0, 1), b2 + hstep, voffB);
            PG8_WAIT_V(6); PG8_BAR; PG8_MMA(1, 1, At, B1); PG8_BAR;
            PG8_LDB(B0, 1, 0); PG8_SCHED; PG8_LDA(At, 1, 0); PG8_STAGE(PG8_SA(0, 1), a2 + hstep, voffA);
            PG8_WAIT_L(8); PG8_BAR; PG8_WAIT_L(0); PG8_MMA(0, 0, At, B0); PG8_BAR; PG8_SCHED;
            PG8_LDB(B1, 1, 1); PG8_STAGE(PG8_SB(1, 0), b3, voffB);
            PG8_BAR; PG8_WAIT_L(0); PG8_MMA(0, 1, At, B1); PG8_BAR;
            PG8_LDA(At, 1, 1); PG8_STAGE(PG8_SA(1, 0), a3, voffA);
            PG8_BAR; PG8_WAIT_L(0); PG8_MMA(1, 0, At, B0); PG8_BAR; PG8_SCHED;
            PG8_STAGE(PG8_SB(1, 1), b3 + hstep, voffB);
            PG8_WAIT_V(6); PG8_BAR; PG8_MMA(1, 1, At, B1); PG8_BAR;
        }
        if constexpr (!Epi::AFTER_DRAIN) { E(acc, cur, wr, wc, fr, fq); S.done(cur); }
        if (!has_next) break;
#pragma unroll
        for (int a = 0; a < 2; ++a)
#pragma unroll
            for (int b = 0; b < 2; ++b)
#pragma unroll
                for (int m = 0; m < 4; ++m)
#pragma unroll
                    for (int n = 0; n < 2; ++n) acc[a][b][m][n] = (f32x4){0.f, 0.f, 0.f, 0.f};
        cur = nxt; cA = nA; cB = nB; ++ui;
    }
    PG8_WAIT_V(0);
    if (wr == 0) PG8_BAR;
    PG8_BAR;
    if constexpr (Epi::AFTER_DRAIN) { E.fused(acc, cur, wr, wc, fr, fq, lds, wid, lane); S.done(cur); }
#undef PG8_SA
#undef PG8_SB
#undef PG8_STAGE
#undef PG8_LDA
#undef PG8_LDB
#undef PG8_MMA
#undef PG8_WAIT_V
#undef PG8_WAIT_L
#undef PG8_BAR
#undef PG8_SCHED
}
}

namespace attn {
using bf16 = __hip_bfloat16;
constexpr int   D = 128, NW = 8, QBLK = 32, KVBLK = 64;
constexpr float SCALE = 0.088388347648318440f;
constexpr float THR = 8.f;
constexpr int SDEPTH = 2;
constexpr int LDQ = 3584, LDK = 3584, LDO = 1024;
constexpr size_t SHM_V = KVBLK * D * 2, SHM_K = KVBLK * D * 2, SHM_ATTN = 2 * SHM_V + 2 * SHM_K + NW * 64 * 4;
__device__ __forceinline__ unsigned short f2bf_rne(float f) { unsigned u = __float_as_uint(f); u += 0x7FFFu + ((u >> 16) & 1u); return (unsigned short)(u >> 16); }
using bf16x8 = __attribute__((ext_vector_type(8))) short;
using s16x4  = __attribute__((ext_vector_type(4))) short;
using f32x16 = __attribute__((ext_vector_type(16))) float;
using f32x8  = __attribute__((ext_vector_type(8))) float;
using u32x4  = __attribute__((ext_vector_type(4))) unsigned;
#define KSWZ(row, colB) ((row) * 256 + ((colB) ^ (((row) & 7) << 4)))
#define SBAR() __builtin_amdgcn_sched_barrier(0)
__device__ __forceinline__ int crow(int r, int hi) { return (r & 3) + 8 * (r >> 2) + 4 * hi; }
__device__ __forceinline__ unsigned cvtpk(float lo, float hi) {
  unsigned r; asm volatile("v_cvt_pk_bf16_f32 %0, %1, %2" : "=v"(r) : "v"(lo), "v"(hi)); return r;
}
template <typename TIn> struct Stage;
template <> struct Stage<bf16>  { using T = bf16x8;
  __device__ static __forceinline__ T ld8(const bf16* p) { return *reinterpret_cast<const bf16x8*>(p); }
  __device__ static __forceinline__ bf16x8 tobf(T x) { return x; } };
template <> struct Stage<float> { using T = f32x8;
  __device__ static __forceinline__ T ld8(const float* p) { return *reinterpret_cast<const f32x8*>(p); }
  __device__ static __forceinline__ bf16x8 tobf(T x) {
    u32x4 w = {cvtpk(x[0], x[1]), cvtpk(x[2], x[3]), cvtpk(x[4], x[5]), cvtpk(x[6], x[7])}; return *reinterpret_cast<bf16x8*>(&w); } };

__device__ __forceinline__ void partialSM(f32x16& p0, f32x16& p1, float& m_reg, float& mn, float& alpha) {
  constexpr float C = SCALE * 1.4426950408889634f;
  float pmax = p0[0]; for (int r = 1; r < 16; ++r) pmax = fmaxf(pmax, p0[r]); for (int r = 0; r < 16; ++r) pmax = fmaxf(pmax, p1[r]);
  { auto rr = __builtin_amdgcn_permlane32_swap(__float_as_uint(pmax), __float_as_uint(pmax), false, false);
    pmax = fmaxf(__uint_as_float(rr[0]), __uint_as_float(rr[1])); }
  if (__builtin_expect(__all(pmax - m_reg <= THR / SCALE), 1)) { mn = m_reg; alpha = 1.f; }
  else { mn = fmaxf(m_reg, pmax); alpha = __builtin_amdgcn_exp2f((m_reg - mn) * C); m_reg = mn; }
  float mnC = -mn * C;
  for (int r = 0; r < 16; ++r) p0[r] = fmaf(p0[r], C, mnC); for (int r = 0; r < 16; ++r) p1[r] = fmaf(p1[r], C, mnC);
  for (int r = 0; r < 16; ++r) p0[r] = __builtin_amdgcn_exp2f(p0[r]);
}
__device__ __forceinline__ void finishSM(f32x16& p0, f32x16& p1, float alpha, float& l_reg, bf16x8& pa0, bf16x8& pa1, bf16x8& pa2, bf16x8& pa3) {
  for (int r = 0; r < 16; ++r) p1[r] = __builtin_amdgcn_exp2f(p1[r]);
  float ps = 0; for (int r = 0; r < 16; ++r) ps += p0[r]; for (int r = 0; r < 16; ++r) ps += p1[r];
  { auto rr = __builtin_amdgcn_permlane32_swap(__float_as_uint(ps), __float_as_uint(ps), false, false);
    ps = __uint_as_float(rr[0]) + __uint_as_float(rr[1]); }
  l_reg = l_reg * alpha + ps;
#define PK4(P, BASE, OUT) do { unsigned a0 = cvtpk(P[BASE + 0], P[BASE + 1]), a1 = cvtpk(P[BASE + 2], P[BASE + 3]);   \
    unsigned b0 = cvtpk(P[BASE + 4], P[BASE + 5]), b1 = cvtpk(P[BASE + 6], P[BASE + 7]);                              \
    auto r0 = __builtin_amdgcn_permlane32_swap(a0, b0, false, false); auto r1 = __builtin_amdgcn_permlane32_swap(a1, b1, false, false); \
    u32x4 w = {r0[0], r1[0], r0[1], r1[1]}; OUT = *reinterpret_cast<bf16x8*>(&w); } while (0)
  PK4(p0, 0, pa0); PK4(p0, 8, pa1); PK4(p1, 0, pa2); PK4(p1, 8, pa3);
#undef PK4
}
__device__ __forceinline__ void qkt(f32x16& p0, f32x16& p1, const bf16* Ks, const bf16x8* qr, int r32, int hi) {
  p0 = f32x16{}; p1 = f32x16{};
  for (int d0 = 0; d0 < 8; ++d0) { int cb = (d0 * 16 + hi * 8) * 2;
    bf16x8 b0 = *reinterpret_cast<const bf16x8*>((const char*)Ks + KSWZ(r32, cb));
    bf16x8 b1 = *reinterpret_cast<const bf16x8*>((const char*)Ks + KSWZ(32 + r32, cb));
    p0 = __builtin_amdgcn_mfma_f32_32x32x16_bf16(b0, qr[d0], p0, 0, 0, 0);
    p1 = __builtin_amdgcn_mfma_f32_32x32x16_bf16(b1, qr[d0], p1, 0, 0, 0); }
}
__device__ __forceinline__ int v_st(int k, int c) { const int kk = (k & ~0xC) | ((k & 4) << 1) | ((k & 8) >> 1); return ((kk >> 3) * 4 + (c >> 5)) * 512 + ((kk & 7) * 32 + (c & 31)) * 2; }
__device__ __forceinline__ int v_rd_base(int lane) { return ((lane & 3) << 3) | (((lane >> 2) & 3) << 6) | (((lane >> 4) & 1) << 5) | (((lane >> 5) & 1) << 8); }
constexpr int v_rd_off(int d0, int ks, int half) { return d0 * 512 + ks * 4096 + half * 2048; }
template <int OFF> __device__ __forceinline__ s16x4 tr_read(int vb) {
  s16x4 r; asm volatile("ds_read_b64_tr_b16 %0, %1 offset:%2" : "=&v"(r) : "v"(vb), "i"(OFF) : "memory"); return r;
}
template <int D0> __device__ __forceinline__ void pv_one(f32x16& od, int vb, bf16x8 pa0, bf16x8 pa1, bf16x8 pa2, bf16x8 pa3) {
  const s16x4 l0 = tr_read<v_rd_off(D0, 0, 0)>(vb), h0 = tr_read<v_rd_off(D0, 0, 1)>(vb), l1 = tr_read<v_rd_off(D0, 1, 0)>(vb), h1 = tr_read<v_rd_off(D0, 1, 1)>(vb);
  const s16x4 l2 = tr_read<v_rd_off(D0, 2, 0)>(vb), h2 = tr_read<v_rd_off(D0, 2, 1)>(vb), l3 = tr_read<v_rd_off(D0, 3, 0)>(vb), h3 = tr_read<v_rd_off(D0, 3, 1)>(vb);
  asm volatile("s_waitcnt lgkmcnt(0)" ::: "memory"); SBAR();
#define PK(L, H) (bf16x8){L[0], L[1], L[2], L[3], H[0], H[1], H[2], H[3]}
  od = __builtin_amdgcn_mfma_f32_32x32x16_bf16(pa0, PK(l0, h0), od, 0, 0, 0);
  od = __builtin_amdgcn_mfma_f32_32x32x16_bf16(pa1, PK(l1, h1), od, 0, 0, 0);
  od = __builtin_amdgcn_mfma_f32_32x32x16_bf16(pa2, PK(l2, h2), od, 0, 0, 0);
  od = __builtin_amdgcn_mfma_f32_32x32x16_bf16(pa3, PK(l3, h3), od, 0, 0, 0);
#undef PK
}
__device__ __forceinline__ void pv_d0(f32x16* o, int vb, bf16x8 pa0, bf16x8 pa1, bf16x8 pa2, bf16x8 pa3) {
  pv_one<0>(o[0], vb, pa0, pa1, pa2, pa3); pv_one<1>(o[1], vb, pa0, pa1, pa2, pa3); pv_one<2>(o[2], vb, pa0, pa1, pa2, pa3); pv_one<3>(o[3], vb, pa0, pa1, pa2, pa3);
}

template <typename TQ>
__device__ __forceinline__ void attn_dense_body(const TQ* __restrict__ Qb, const bf16* __restrict__ Kh, const bf16* __restrict__ Vh,
                                                unsigned short* __restrict__ Ob, int seq, char* lds, const float* __restrict__ qg, int pos0) {
  using St = Stage<bf16>; using SQ = Stage<TQ>;
  int tid_ = threadIdx.x; asm volatile("" : "+v"(tid_));
  const int tid = tid_, wid = tid >> 6, lane = tid & 63, r32 = lane & 31, hi = lane >> 5;
  bf16* V_lds = (bf16*)lds; bf16* K_lds = (bf16*)(lds + 2 * SHM_V);
  float* ws = (float*)(lds + 2 * SHM_V + 2 * SHM_K) + wid * 64; float* li_l = ws; float* al_l = ws + 32;
  float m_reg = -1e30f, l_reg = 0; f32x16 o[4] = {}; bf16x8 qr[8];
  const TQ* Qw = Qb + (long)(wid * QBLK + r32) * LDQ + hi * 8;
#pragma unroll
  for (int d0 = 0; d0 < 8; ++d0) qr[d0] = SQ::tobf(SQ::ld8(Qw + d0 * 16));
  {
#define QF(d0, jj) __uint_as_float(((unsigned)(unsigned short)qr[d0][jj]) << 16)
    int hi2 = hi; asm volatile("" : "+v"(hi2));
    const float* qg2 = qg; asm volatile("" : "+s"(qg2));
    float ss = 0.f;
#pragma unroll
    for (int d0 = 0; d0 < 8; ++d0)
#pragma unroll
      for (int jj = 0; jj < 8; ++jj) { const float x = QF(d0, jj); ss += x * x; }
    ss += __shfl_xor(ss, 32);
    const float ri = rsqrtf(ss * (1.0f / 128.0f) + 1e-6f);
    const int pos = pos0 + wid * QBLK + r32; const float prow = (float)(pos >> 6), pcol = (float)(pos & 63);
    u32x4 qv[8];
#pragma unroll
    for (int d0 = 0; d0 < 8; ++d0) qv[d0] = *reinterpret_cast<u32x4*>(&qr[d0]);
#pragma unroll
    for (int dd = 0; dd < 2; ++dd)
#pragma unroll
      for (int jp = 0; jp < 4; ++jp) { float o[4][2];
#pragma unroll
        for (int u = 0; u < 2; ++u) { const int jj = 2 * jp + u, e0 = 16 * dd + 8 * hi2 + jj;
          const float invf = exp2f(-(float)e0 * (13.287712379549449f / 32.0f));
          const float ar = prow * invf, ac = pcol * invf;
          const float sr_ = __sinf(ar), cr_ = __cosf(ar), sc_ = __sinf(ac), cc_ = __cosf(ac);
#define QW(d0) (u ? __uint_as_float(qv[d0][jp] & 0xffff0000u) : __uint_as_float(qv[d0][jp] << 16))
          const float a1 = QW(dd) * ri * qg2[e0], a2 = QW(dd + 2) * ri * qg2[32 + e0], b1 = QW(4 + dd) * ri * qg2[64 + e0], b2 = QW(6 + dd) * ri * qg2[96 + e0];
#undef QW
          o[0][u] = a1 * cr_ - a2 * sr_; o[1][u] = a2 * cr_ + a1 * sr_; o[2][u] = b1 * cc_ - b2 * sc_; o[3][u] = b2 * cc_ + b1 * sc_; }
        qv[dd][jp] = cvtpk(o[0][0], o[0][1]); qv[dd + 2][jp] = cvtpk(o[1][0], o[1][1]); qv[4 + dd][jp] = cvtpk(o[2][0], o[2][1]); qv[6 + dd][jp] = cvtpk(o[3][0], o[3][1]); }
#pragma unroll
    for (int d0 = 0; d0 < 8; ++d0) qr[d0] = *reinterpret_cast<bf16x8*>(&qv[d0]);
#undef QF
  }
  const int sr = tid >> 4, sc = (tid & 15) * 8, vst0 = v_st(sr, sc), vst1 = v_st(32 + sr, sc);
  const int vb0 = (int)(uintptr_t)V_lds + v_rd_base(lane);
  struct { typename St::T vs0, vs1, ks0, ks1; } sr_[SDEPTH];
#define SLOAD(i, k0) do { sr_[i].vs0 = St::ld8(&Vh[(long)((k0) + sr) * LDK + sc]); sr_[i].vs1 = St::ld8(&Vh[(long)((k0) + 32 + sr) * LDK + sc]); \
    sr_[i].ks0 = St::ld8(&Kh[(long)((k0) + sr) * LDK + sc]); sr_[i].ks1 = St::ld8(&Kh[(long)((k0) + 32 + sr) * LDK + sc]); } while (0)
#define SWRITE(b, i) do { *(bf16x8*)((char*)V_lds + (b) * SHM_V + vst0) = St::tobf(sr_[i].vs0);          \
    *(bf16x8*)((char*)V_lds + (b) * SHM_V + vst1) = St::tobf(sr_[i].vs1); int kc = sc * 2;               \
    *(bf16x8*)((char*)K_lds + (b) * SHM_K + KSWZ(sr, kc)) = St::tobf(sr_[i].ks0);                       \
    *(bf16x8*)((char*)K_lds + (b) * SHM_K + KSWZ(32 + sr, kc)) = St::tobf(sr_[i].ks1); } while (0)
#define SWAIT() do { if constexpr (SDEPTH == 2) asm volatile("s_waitcnt vmcnt(4)" ::: "memory"); else asm volatile("s_waitcnt vmcnt(0)" ::: "memory"); } while (0)
#define RESC(a) do { if (__any((a) < 1.f)) { if (hi == 0) al_l[r32] = (a); asm volatile("s_waitcnt lgkmcnt(0)" ::: "memory"); \
    for (int d = 0; d < 4; ++d) for (int r = 0; r < 16; ++r) o[d][r] *= al_l[crow(r, hi)]; } } while (0)
  f32x16 pA0, pA1, pB0, pB1; float mnA, mnB, alA, alB; bf16x8 pa0, pa1, pa2, pa3; const int NT = seq / KVBLK;
  constexpr int SE = 0, SO = SDEPTH - 1;
  SLOAD(SE, 0); asm volatile("s_waitcnt vmcnt(0)" ::: "memory"); SWRITE(0, SE); __syncthreads();
  qkt(pA0, pA1, K_lds, qr, r32, hi); partialSM(pA0, pA1, m_reg, mnA, alA);
  SLOAD(SO, KVBLK); if constexpr (SDEPTH == 2) { if (2 < NT) SLOAD(SE, 2 * KVBLK); }
  SWAIT(); SWRITE(1, SO); __syncthreads();
  for (int j = 1; j + 1 < NT; j += 2) {
    SBAR(); qkt(pB0, pB1, (bf16*)((char*)K_lds + SHM_K), qr, r32, hi);
    finishSM(pA0, pA1, alA, l_reg, pa0, pa1, pa2, pa3); SBAR();
    SLOAD(SO, (j + SDEPTH) * KVBLK); SBAR();
    pv_d0(o, vb0, pa0, pa1, pa2, pa3); partialSM(pB0, pB1, m_reg, mnB, alB);
    __syncthreads(); SWAIT(); SWRITE(0, SE);
    RESC(alB); __syncthreads();
    SBAR(); qkt(pA0, pA1, K_lds, qr, r32, hi);
    finishSM(pB0, pB1, alB, l_reg, pa0, pa1, pa2, pa3); SBAR();
    if (SDEPTH == 1 || j + 3 < NT) SLOAD(SE, (j + 1 + SDEPTH) * KVBLK); SBAR();
    pv_d0(o, vb0 + (int)SHM_V, pa0, pa1, pa2, pa3); partialSM(pA0, pA1, m_reg, mnA, alA);
    __syncthreads(); SWAIT(); SWRITE(1, SO);
    RESC(alA); __syncthreads();
  }
  SBAR(); qkt(pB0, pB1, (bf16*)((char*)K_lds + SHM_K), qr, r32, hi);
  finishSM(pA0, pA1, alA, l_reg, pa0, pa1, pa2, pa3); SBAR();
  pv_d0(o, vb0, pa0, pa1, pa2, pa3); partialSM(pB0, pB1, m_reg, mnB, alB);
  __syncthreads(); RESC(alB);
  finishSM(pB0, pB1, alB, l_reg, pa0, pa1, pa2, pa3); SBAR();
  pv_d0(o, vb0 + (int)SHM_V, pa0, pa1, pa2, pa3);
  if (hi == 0) li_l[r32] = l_reg; asm volatile("s_waitcnt lgkmcnt(0)" ::: "memory");
  float rli[16];
#pragma unroll
  for (int r = 0; r < 16; ++r) rli[r] = __builtin_amdgcn_rcpf(li_l[crow(r, hi)]);
  unsigned short* Ow = Ob + (long)(wid * QBLK) * LDO;
#pragma unroll
  for (int r = 0; r < 16; ++r) { int orow = crow(r, hi);
    for (int d0 = 0; d0 < 4; ++d0) Ow[(long)orow * LDO + d0 * 32 + r32] = f2bf_rne(o[d0][r] * rli[r]); }
#undef SLOAD
#undef SWRITE
#undef SWAIT
#undef RESC
}
#undef KSWZ
#undef SBAR
}

#define XB_TMO      128
#define XB_XCNT(j)  (256  + 64 * (j))
#define XB_XSUB(j)  (1280 + 64 * (j))
#define XB_XGEN(j)  (2304 + 64 * (j))
#define XB_TOP      3328
#define XB_TOPGEN   3392
#define XCD_BAR_WORDS 3456
#define XB_SPIN_CAP (1u << 18)
#define LAS __attribute__((address_space(3)))

__device__ __forceinline__ unsigned xb_ld(unsigned* p)              { return __hip_atomic_load(p, __ATOMIC_RELAXED, __HIP_MEMORY_SCOPE_AGENT); }
__device__ __forceinline__ unsigned xb_add(unsigned* p, unsigned v) { return __hip_atomic_fetch_add(p, v, __ATOMIC_RELAXED, __HIP_MEMORY_SCOPE_AGENT); }
__device__ __forceinline__ unsigned xb_xcc_id() { return (unsigned)__builtin_amdgcn_s_getreg((3 << 11) | 20) & 0xFu; }
#define XB_SPIN(cond, bar) do { unsigned _sp = 0; while (cond) { __builtin_amdgcn_s_sleep(1); \
    if ((++_sp & 255u) == 0u) { if (xb_ld(&(bar)[XB_TMO])) break; if (_sp > XB_SPIN_CAP) { atomicAdd(&(bar)[XB_TMO], 1u); break; } } } } while (0)

struct XcdBarrier {
    unsigned* bar; unsigned x; unsigned gsz;
    volatile LAS unsigned* st;
};

__device__ __forceinline__ XcdBarrier xcd_barrier_post(unsigned* bar, volatile LAS unsigned* st) {
    XcdBarrier b; b.bar = bar; b.x = xb_xcc_id(); b.st = st;
    if (threadIdx.x == 0) (void)xb_add(&bar[XB_XCNT(b.x)], 1u);
    return b;
}
__device__ __forceinline__ void xcd_barrier_complete(unsigned* bar, unsigned x, unsigned& nloc, unsigned& nx, unsigned G) {
    unsigned sum, cnt, mine, sp = 0u;
    for (;;) {
        sum = 0u; cnt = 0u; mine = 0u;
#pragma unroll
        for (unsigned j = 0; j < 16; ++j) { const unsigned c = xb_ld(&bar[XB_XCNT(j)]); sum += c; cnt += (c > 0u) ? 1u : 0u; mine = (j == x) ? c : mine; }
        if (sum == G) break;
        __builtin_amdgcn_s_sleep(1);
        if ((++sp & 255u) == 0u) { if (xb_ld(&bar[XB_TMO])) break; if (sp > XB_SPIN_CAP) { atomicAdd(&bar[XB_TMO], 1u); break; } }
    }
    nloc = mine > 0u ? mine : 1u; nx = cnt > 0u ? cnt : 1u;
}

__device__ __forceinline__ void xcd_barrier(const XcdBarrier& b) {
    asm volatile("s_waitcnt vmcnt(0)" ::: "memory");
    __syncthreads();
    if (threadIdx.x == 0) {
        unsigned* bar = b.bar;
        __builtin_amdgcn_s_waitcnt(0);
        unsigned nloc = b.st[0], nx = b.st[1];
        if (nloc == 0u) { xcd_barrier_complete(bar, b.x, nloc, nx, b.gsz); b.st[0] = nloc; b.st[1] = nx; }
        const unsigned old = xb_add(&bar[XB_XSUB(b.x)], 1u);
        const unsigned gen = old / nloc;
        if (old + 1u == (gen + 1u) * nloc) {
            __builtin_amdgcn_fence(__ATOMIC_RELEASE, "agent");
            asm volatile("s_waitcnt vmcnt(0)" ::: "memory");
            const unsigned og = xb_add(&bar[XB_TOP], 1u);
            const unsigned tg = og / nx;
            if (og + 1u == (tg + 1u) * nx) xb_add(&bar[XB_TOPGEN], 1u);
            else XB_SPIN(xb_ld(&bar[XB_TOPGEN]) == tg, bar);
            __builtin_amdgcn_fence(__ATOMIC_ACQUIRE, "agent");
            xb_add(&bar[XB_XGEN(b.x)], 1u);
            asm volatile("s_waitcnt vmcnt(0)" ::: "memory");
        } else {
            XB_SPIN(xb_ld(&bar[XB_XGEN(b.x)]) == gen, bar);
            __builtin_amdgcn_fence(__ATOMIC_ACQUIRE, "agent");
            asm volatile("s_waitcnt vmcnt(0)" ::: "memory");
        }
    }
    __syncthreads();
}

namespace mk {
using pg8::bf16_t; using pg8::bf16x8; using pg8::f32x4; using pg8::u32x4; using pg8::cvt_pk_bf16; using pg8::bf_lo; using pg8::bf_hi;
typedef unsigned u32x2 __attribute__((ext_vector_type(2)));
constexpr int T = 32768, DM = 1024, FF = 2816, SEQ = 2048, NZ1 = 4096, NZ2 = 3584, NWIN = 6688;
constexpr float EPS = 1e-6f;
constexpr size_t MiB = (size_t)1 << 20, HMiB = (size_t)1 << 19;
constexpr size_t WS_W1IN = 0, WS_W1OUT = 11 * MiB, WS_WIN = 16 * MiB + HMiB, WS_WA = 31 * MiB + HMiB, WS_WB = 33 * MiB + HMiB, WS_WO = 35 * MiB + HMiB,
                 WS_W2IN = 37 * MiB + HMiB, WS_W2OUT = 48 * MiB + HMiB, WS_XN = 56 * MiB, WS_F = 120 * MiB, WS_Z = 184 * MiB, WS_OG = 440 * MiB, WS_CTL = 504 * MiB, WS_RN = 504 * MiB + 65536, WS_END = 504 * MiB + 65536 + 131072;
constexpr int LDS_BYTES = 149504 + 16;
#define LBAR() do { asm volatile("s_waitcnt lgkmcnt(0)" ::: "memory"); __builtin_amdgcn_s_barrier(); asm volatile("" ::: "memory"); } while (0)

__device__ __forceinline__ float wave_sum(float v) {
#pragma unroll
    for (int o = 32; o > 0; o >>= 1) v += __shfl_xor(v, o);
    return v;
}

enum { CM_ID = 0, CM_SWIGLU = 1, CM_WIN_A = 2, CM_WIN_B = 3, CM_FOLD = 4 };
__device__ __forceinline__ void cvt_job(int& tbase, const float* __restrict__ src, int Nsrc, int K, bf16_t* __restrict__ dst, int ndst, int mode,
                                        const float* __restrict__ gain, const float* __restrict__ up_f, const float* __restrict__ up_b, int bi, int nb) {
    const int lane = threadIdx.x & 63, gw = bi * 8 + (threadIdx.x >> 6), nw = nb * 8;
    const int nT = ndst >> 6, kT = K >> 6, ntile = nT * kT;
    int t0 = (gw - tbase % nw + nw) % nw; tbase += ntile;
    for (int t = t0; t < ntile; t += nw) {
        const int n0 = (t % nT) << 6, k0 = (t / nT) << 6, n = n0 + lane;
        int col = n; float scale = 1.f;
        if (mode == CM_SWIGLU) { const int j = n & 255, pn = n >> 8; col = (j < 128) ? pn * 128 + j : FF + pn * 128 + (j - 128); }
        else if (mode == CM_WIN_A) { scale = (n < 512) ? 0.08838834764831845f : 1.f; }
        else if (mode == CM_WIN_B) { col = 3104 + n; }
        float v[64];
        if (mode == CM_FOLD) {
            const int dirb = n >> 9, c = n & 511; const float* up = dirb ? up_b : up_f;
            float upv[16];
#pragma unroll
            for (int r = 0; r < 16; ++r) upv[r] = up[r * 512 + c];
#pragma unroll
            for (int j = 0; j < 64; ++j) { const float* wp = src + (size_t)(k0 + j) * Nsrc + 3072 + 16 * dirb; float sacc = 0.f;
#pragma unroll
                for (int r = 0; r < 16; ++r) sacc += wp[r] * upv[r];
                v[j] = sacc; }
        } else {
            const float* sp = src + (size_t)k0 * Nsrc + col;
#pragma unroll
            for (int j = 0; j < 64; ++j) v[j] = sp[(size_t)j * Nsrc];
        }
        bf16_t* dp = dst + (size_t)n * K + k0;
        if (gain) {
#pragma unroll
            for (int j8 = 0; j8 < 8; ++j8) { const f32x4 g0 = *(const f32x4*)(gain + k0 + 8 * j8), g1 = *(const f32x4*)(gain + k0 + 8 * j8 + 4);
                u32x4 w; w.x = cvt_pk_bf16(v[8 * j8] * g0[0] * scale, v[8 * j8 + 1] * g0[1] * scale); w.y = cvt_pk_bf16(v[8 * j8 + 2] * g0[2] * scale, v[8 * j8 + 3] * g0[3] * scale);
                w.z = cvt_pk_bf16(v[8 * j8 + 4] * g1[0] * scale, v[8 * j8 + 5] * g1[1] * scale); w.w = cvt_pk_bf16(v[8 * j8 + 6] * g1[2] * scale, v[8 * j8 + 7] * g1[3] * scale);
                *(u32x4*)(dp + 8 * j8) = w; }
        } else {
#pragma unroll
            for (int j8 = 0; j8 < 8; ++j8) { u32x4 w; w.x = cvt_pk_bf16(v[8 * j8], v[8 * j8 + 1]); w.y = cvt_pk_bf16(v[8 * j8 + 2], v[8 * j8 + 3]);
                w.z = cvt_pk_bf16(v[8 * j8 + 4], v[8 * j8 + 5]); w.w = cvt_pk_bf16(v[8 * j8 + 6], v[8 * j8 + 7]); *(u32x4*)(dp + 8 * j8) = w; }
        }
    }
}
__device__ __forceinline__ float sq4(const f32x4 v) { return v[0] * v[0] + v[1] * v[1] + v[2] * v[2] + v[3] * v[3]; }
__device__ __forceinline__ void rows_prenorm(const float* __restrict__ x, bf16_t* __restrict__ XN, float* __restrict__ RN, int bi, int nb, int nrows) {
    const int lane = threadIdx.x & 63, gw = bi * 8 + (threadIdx.x >> 6), nw = nb * 8;
    for (int row = gw; row < nrows; row += 2 * nw) {
        f32x4 v[2][4]; float ss[2] = {0.f, 0.f};
#pragma unroll
        for (int u = 0; u < 2; ++u) { const float* xp = x + (size_t)(row + u * nw) * DM + 4 * lane;
#pragma unroll
            for (int c = 0; c < 4; ++c) v[u][c] = *(const f32x4*)(xp + 256 * c); }
#pragma unroll
        for (int u = 0; u < 2; ++u) {
#pragma unroll
            for (int c = 0; c < 4; ++c) ss[u] += sq4(v[u][c]);
            ss[u] = wave_sum(ss[u]); const float ms = ss[u] * (1.0f / DM) + EPS, ri = rsqrtf(ms);
            if (lane == 0) RN[row + u * nw] = ms * ri;
            bf16_t* op = XN + (size_t)(row + u * nw) * DM + 4 * lane;
#pragma unroll
            for (int c = 0; c < 4; ++c) { u32x2 w; w.x = cvt_pk_bf16(v[u][c][0] * ri, v[u][c][1] * ri); w.y = cvt_pk_bf16(v[u][c][2] * ri, v[u][c][3] * ri); *(u32x2*)(op + 256 * c) = w; } }
    }
}
template <int BASE_BF16  , bool OUT_BF16>
__device__ __forceinline__ void rows_resnorm(const bf16_t* __restrict__ F, const void* base, const float* __restrict__ gain, float coef, void* __restrict__ out, bf16_t* XN, const float* __restrict__ rn, int bi, int nb, int nrows) {
    const int lane = threadIdx.x & 63, gw = bi * 8 + (threadIdx.x >> 6), nw = nb * 8;
    f32x4 g[4];
#pragma unroll
    for (int c = 0; c < 4; ++c) g[c] = *(const f32x4*)(gain + 256 * c + 4 * lane);
    for (int row = gw; row < nrows; row += 2 * nw) {
        f32x4 f[2][4], h[2][4];
#pragma unroll
        for (int u = 0; u < 2; ++u) { const size_t ro = (size_t)(row + u * nw) * DM + 4 * lane;
#pragma unroll
            for (int c = 0; c < 4; ++c) { const u32x2 w = *(const u32x2*)(F + ro + 256 * c); f[u][c] = (f32x4){bf_lo(w.x), bf_hi(w.x), bf_lo(w.y), bf_hi(w.y)};
                if (BASE_BF16) { const u32x2 bw = *(const u32x2*)((const bf16_t*)base + ro + 256 * c); h[u][c] = (f32x4){bf_lo(bw.x), bf_hi(bw.x), bf_lo(bw.y), bf_hi(bw.y)}; if (BASE_BF16 == 2) h[u][c] = h[u][c] * rn[row + u * nw]; }
                else h[u][c] = *(const f32x4*)((const float*)base + ro + 256 * c); } }
#pragma unroll
        for (int u = 0; u < 2; ++u) { const size_t ro = (size_t)(row + u * nw) * DM + 4 * lane; float ss = 0.f;
#pragma unroll
            for (int c = 0; c < 4; ++c) ss += sq4(f[u][c]);
            ss = wave_sum(ss); const float ri = rsqrtf(ss * (1.0f / DM) + EPS) * coef; float s2 = 0.f;
#pragma unroll
            for (int c = 0; c < 4; ++c) { h[u][c] += f[u][c] * g[c] * ri; s2 += sq4(h[u][c]);
                if (OUT_BF16) { u32x2 w; w.x = cvt_pk_bf16(h[u][c][0], h[u][c][1]); w.y = cvt_pk_bf16(h[u][c][2], h[u][c][3]); *(u32x2*)((bf16_t*)out + ro + 256 * c) = w; }
                else *(f32x4*)((float*)out + ro + 256 * c) = h[u][c]; }
            if (XN) { s2 = wave_sum(s2); const float r2 = rsqrtf(s2 * (1.0f / DM) + EPS);
#pragma unroll
                for (int c = 0; c < 4; ++c) { u32x2 w; w.x = cvt_pk_bf16(h[u][c][0] * r2, h[u][c][1] * r2); w.y = cvt_pk_bf16(h[u][c][2] * r2, h[u][c][3] * r2); *(u32x2*)(XN + ro + 256 * c) = w; } } }
    }
}
__device__ __forceinline__ void rows_gla_merge(bf16_t* OF, const bf16_t* __restrict__ OB, const bf16_t* __restrict__ Z1, const float* __restrict__ og, int bi, int nb, int nrows) {
    const int lane = threadIdx.x & 63, gw = bi * 8 + (threadIdx.x >> 6), nw = nb * 8;
    f32x4 g[4];
#pragma unroll
    for (int c = 0; c < 4; ++c) g[c] = *(const f32x4*)(og + 256 * c + 4 * lane);
    for (int row = gw; row < nrows; row += 2 * nw) {
        u32x2 ra[2][4], rb[2][4], rr_[2][4];
#pragma unroll
        for (int u = 0; u < 2; ++u) { const size_t ro = (size_t)(row + u * nw) * DM + 4 * lane; const bf16_t* zr = Z1 + (size_t)(row + u * nw) * NZ1 + 2048 + 4 * lane;
#pragma unroll
            for (int c = 0; c < 4; ++c) { ra[u][c] = *(const u32x2*)(OF + ro + 256 * c); rb[u][c] = *(const u32x2*)(OB + ro + 256 * c); rr_[u][c] = *(const u32x2*)(zr + 256 * c); } }
#pragma unroll
        for (int u = 0; u < 2; ++u) { const size_t ro = (size_t)(row + u * nw) * DM + 4 * lane;
#pragma unroll
            for (int c = 0; c < 4; ++c) { const u32x2 a = ra[u][c], b = rb[u][c], r = rr_[u][c];
                f32x4 o = (f32x4){bf_lo(a.x) + bf_lo(b.x), bf_hi(a.x) + bf_hi(b.x), bf_lo(a.y) + bf_lo(b.y), bf_hi(a.y) + bf_hi(b.y)};
                float ss = wave_sum(o[0] * o[0] + o[1] * o[1] + o[2] * o[2] + o[3] * o[3]); const float ri = rsqrtf(ss * (1.0f / 256.0f) + EPS);
                const f32x4 rr = (f32x4){bf_lo(r.x), bf_hi(r.x), bf_lo(r.y), bf_hi(r.y)}; o = o * g[c] * rr * ri;
                u32x2 w; w.x = cvt_pk_bf16(o[0], o[1]); w.y = cvt_pk_bf16(o[2], o[3]); *(u32x2*)(OF + ro + 256 * c) = w; } }
    }
}
__device__ __forceinline__ void rows_rope(bf16_t* Z2, const float* __restrict__ qg, const float* __restrict__ kg, int bi, int nb, int nrows) {
    const int lane = threadIdx.x & 63, gw = bi * 8 + (threadIdx.x >> 6), nw = nb * 8;
    const int e0 = 2 * lane, jf = e0 & 31;
    const float if0 = exp2f(-(float)jf * (13.287712379549449f / 32.0f)), if1 = exp2f(-(float)(jf + 1) * (13.287712379549449f / 32.0f));
    const float gq0 = qg[e0], gq1 = qg[e0 + 1], gk0 = kg[e0], gk1 = kg[e0 + 1];
    const bool second = (e0 & 32) != 0;
    for (int tok = gw; tok < nrows; tok += 4 * nw) {
        unsigned xr[4][10];
#pragma unroll
        for (int u = 0; u < 4; ++u) { const unsigned* bp = (const unsigned*)(Z2 + (size_t)(tok + u * nw) * NZ2) + lane;
#pragma unroll
            for (int hh = 8; hh < 10; ++hh) xr[u][hh] = bp[hh * 64]; }
#pragma unroll
        for (int u = 0; u < 4; ++u) { const int t = tok + u * nw, pos = t & (SEQ - 1);
            const float p = (float)((lane < 32) ? (pos >> 6) : (pos & 63));
            float s0, c0, s1, c1; sincosf(p * if0, &s0, &c0); sincosf(p * if1, &s1, &c1);
            if (!second) { s0 = -s0; s1 = -s1; }
            unsigned* op = (unsigned*)(Z2 + (size_t)t * NZ2) + lane;
#pragma unroll
            for (int hh = 8; hh < 10; ++hh) { const float x0 = bf_lo(xr[u][hh]), x1 = bf_hi(xr[u][hh]);
                const float ss = wave_sum(x0 * x0 + x1 * x1), ri = rsqrtf(ss * (1.0f / 128.0f) + EPS);
                const float y0 = x0 * ri * (hh < 8 ? gq0 : gk0), y1 = x1 * ri * (hh < 8 ? gq1 : gk1);
                const float z0 = __shfl_xor(y0, 16), z1 = __shfl_xor(y1, 16);
                op[hh * 64] = cvt_pk_bf16(y0 * c0 + z0 * s0, y1 * c1 + z1 * s1); }
        }
    }
}
__device__ __forceinline__ void gla_phase(unsigned char* lds, const bf16_t* __restrict__ Z1, bf16_t* __restrict__ Of, bf16_t* __restrict__ Ob, int bi, int nb, int nitems) {
    int tid_ = threadIdx.x; asm volatile("" : "+v"(tid_));
    const int tid = tid_, lane = tid & 63, w = tid >> 6, r = lane & 15, q = lane >> 4;
    constexpr int QS_B = 64 * 136 * 2, KD_B = 128 * 72 * 2, VT_B = 128 * 72 * 2, PP_B = 64 * 72 * 2, DEC_B = 512, BUF_B = QS_B + KD_B + VT_B + PP_B + DEC_B;
    bf16_t* KS = (bf16_t*)(lds + 2 * BUF_B);
    float* SEG = (float*)(lds + 2 * BUF_B + QS_B);
    const int d2 = lane * 2;
#define GLA_WAIT() do { asm volatile("s_waitcnt lgkmcnt(0)" ::: "memory"); __builtin_amdgcn_sched_barrier(0); } while (0)
    for (int it0 = bi; it0 < nitems; it0 += nb) {
        const int item = (nitems == 128 && nb == 128) ? ((it0 & 3) * 32 + (it0 >> 2)) : it0;
        const int dir = item & 1, dvs = (item >> 1) & 1, h = (item >> 2) & 3, b = item >> 4;
        const bf16_t* zq = Z1 + (size_t)(b * SEQ + 8 * w) * NZ1 + h * 128 + d2;
        const bf16_t* zk = zq + 512;
        const bf16_t* zv = Z1 + (size_t)(b * SEQ + 8 * w) * NZ1 + 1024 + h * 256 + dvs * 128 + d2;
        const bf16_t* zg = zq + 3072 + dir * 512;
        bf16_t* og = (dir ? Ob : Of) + (size_t)(b * SEQ) * DM + h * 256 + dvs * 128 + 16 * w + r;
        f32x4 S[8];
#pragma unroll
        for (int mb = 0; mb < 8; ++mb) S[mb] = (f32x4){0.f, 0.f, 0.f, 0.f};
        unsigned rq[8], rk[8], rg[8], rv[8];
        { const size_t co = (size_t)((dir ? 31 : 0) * 64) * NZ1;
#pragma unroll
          for (int tt = 0; tt < 8; ++tt) { const size_t o = co + (size_t)tt * NZ1; rq[tt] = *(const unsigned*)(zq + o); rk[tt] = *(const unsigned*)(zk + o); rg[tt] = *(const unsigned*)(zg + o); rv[tt] = *(const unsigned*)(zv + o); } }
        float ga[8], gb[8];
        for (int step = -1; step < 32; ++step) {
            const int c = dir ? 31 - step : step;
            const int cnn = dir ? c - 2 : c + 2;
            const bool prod = step + 1 < 32, cons = step >= 0, pref = step + 2 < 32;
            unsigned char* bx = lds + (step & 1) * BUF_B;
            unsigned char* by = lds + ((step + 1) & 1) * BUF_B;
            bf16_t* QSx = (bf16_t*)bx; bf16_t* KDx = (bf16_t*)(bx + QS_B); bf16_t* VTx = (bf16_t*)(bx + QS_B + KD_B); bf16_t* PPx = (bf16_t*)(bx + QS_B + KD_B + VT_B); float* DECx = (float*)(bx + QS_B + KD_B + VT_B + PP_B);
            bf16_t* QSy = (bf16_t*)by; bf16_t* KDy = (bf16_t*)(by + QS_B); bf16_t* VTy = (bf16_t*)(by + QS_B + KD_B); bf16_t* PPy = (bf16_t*)(by + QS_B + KD_B + VT_B); float* DECy = (float*)(by + QS_B + KD_B + VT_B + PP_B);
            f32x4 O[4];
            O[0] = (f32x4){0.f, 0.f, 0.f, 0.f}; O[1] = O[0]; O[2] = O[0]; O[3] = O[0];
            if (cons) {
                bf16x8 sbf[4];
#pragma unroll
                for (int kk = 0; kk < 4; ++kk) { u32x4 t; t.x = cvt_pk_bf16(S[2 * kk][0], S[2 * kk][1]); t.y = cvt_pk_bf16(S[2 * kk][2], S[2 * kk][3]); t.z = cvt_pk_bf16(S[2 * kk + 1][0], S[2 * kk + 1][1]); t.w = cvt_pk_bf16(S[2 * kk + 1][2], S[2 * kk + 1][3]); sbf[kk] = *reinterpret_cast<bf16x8*>(&t); }
#pragma unroll
                for (int tp = 0; tp < 2; ++tp) { u32x4 af[2][4];
#pragma unroll
                    for (int t2 = 0; t2 < 2; ++t2)
#pragma unroll
                        for (int kk = 0; kk < 4; ++kk) { const bf16_t* ap = QSx + (16 * (2 * tp + t2) + r) * 136 + 32 * kk + 4 * q; const u32x2 lo = *(const u32x2*)ap, hi = *(const u32x2*)(ap + 16); af[t2][kk] = (u32x4){lo.x, lo.y, hi.x, hi.y}; }
                    GLA_WAIT();
#pragma unroll
                    for (int t2 = 0; t2 < 2; ++t2)
#pragma unroll
                        for (int kk = 0; kk < 4; ++kk) O[2 * tp + t2] = __builtin_amdgcn_mfma_f32_16x16x32_bf16(*reinterpret_cast<bf16x8*>(&af[t2][kk]), sbf[kk], O[2 * tp + t2], 0, 0, 0);
                    __builtin_amdgcn_sched_barrier(0); }
            }
            if (prod) {
#pragma unroll
                for (int tt = 0; tt < 8; ++tt) { ga[tt] = bf_lo(rg[tt]); gb[tt] = bf_hi(rg[tt]); }
                if (!dir) {
#pragma unroll
                    for (int tt = 1; tt < 8; ++tt) { ga[tt] += ga[tt - 1]; gb[tt] += gb[tt - 1]; }
                    *(float2*)(SEG + w * 128 + d2) = make_float2(ga[7], gb[7]);
                } else {
#pragma unroll
                    for (int tt = 6; tt >= 0; --tt) { ga[tt] += ga[tt + 1]; gb[tt] += gb[tt + 1]; }
                    *(float2*)(SEG + w * 128 + d2) = make_float2(ga[0], gb[0]);
                }
                { u32x4 va, vb;
                  va.x = (rv[0] & 0xffffu) | (rv[1] << 16); va.y = (rv[2] & 0xffffu) | (rv[3] << 16); va.z = (rv[4] & 0xffffu) | (rv[5] << 16); va.w = (rv[6] & 0xffffu) | (rv[7] << 16);
                  vb.x = (rv[0] >> 16) | (rv[1] & 0xffff0000u); vb.y = (rv[2] >> 16) | (rv[3] & 0xffff0000u); vb.z = (rv[4] >> 16) | (rv[5] & 0xffff0000u); vb.w = (rv[6] >> 16) | (rv[7] & 0xffff0000u);
                  *(u32x4*)(VTy + d2 * 72 + 8 * w) = va; *(u32x4*)(VTy + (d2 + 1) * 72 + 8 * w) = vb; }
                if (pref) { const size_t co = (size_t)(cnn * 64) * NZ1;
#pragma unroll
                    for (int tt = 0; tt < 8; ++tt) { const size_t o = co + (size_t)tt * NZ1; rg[tt] = *(const unsigned*)(zg + o); rv[tt] = *(const unsigned*)(zv + o); } }
            }
            LBAR();
            if (cons) {
                const bf16x8 v0 = *(const bf16x8*)(VTx + (16 * w + r) * 72 + 8 * q), v1 = *(const bf16x8*)(VTx + (16 * w + r) * 72 + 32 + 8 * q);
#pragma unroll
                for (int hb = 0; hb < 2; ++hb) { bf16x8 kd0[4], kd1[4]; f32x4 dc[4];
#pragma unroll
                    for (int m4 = 0; m4 < 4; ++m4) { const int mb = 4 * hb + m4; dc[m4] = *(const f32x4*)(DECx + 16 * mb + 4 * q);
                        kd0[m4] = *(const bf16x8*)(KDx + (16 * mb + r) * 72 + 8 * q); kd1[m4] = *(const bf16x8*)(KDx + (16 * mb + r) * 72 + 32 + 8 * q); }
                    GLA_WAIT();
#pragma unroll
                    for (int m4 = 0; m4 < 4; ++m4) { const int mb = 4 * hb + m4; S[mb] = S[mb] * dc[m4];
                        S[mb] = __builtin_amdgcn_mfma_f32_16x16x32_bf16(kd0[m4], v0, S[mb], 0, 0, 0); S[mb] = __builtin_amdgcn_mfma_f32_16x16x32_bf16(kd1[m4], v1, S[mb], 0, 0, 0); }
                    __builtin_amdgcn_sched_barrier(0); }
            }
            if (prod) {
                float offa = 0.f, offb = 0.f, tota = 0.f, totb = 0.f;
#pragma unroll
                for (int s = 0; s < 8; ++s) { const float2 v = *(const float2*)(SEG + s * 128 + d2); tota += v.x; totb += v.y; const bool inc = dir ? (s > w) : (s < w); offa += inc ? v.x : 0.f; offb += inc ? v.y : 0.f; }
                const float eta = __expf(tota), etb = __expf(totb);
                if (w == 0) *(float2*)(DECy + d2) = make_float2(eta, etb);
                float kda[8], kdb[8];
#pragma unroll
                for (int tt = 0; tt < 8; ++tt) { const float ba = offa + ga[tt], bb = offb + gb[tt];
                    const float ea = __expf(ba), eb = __expf(bb), iea = __expf(-ba), ieb = __expf(-bb);
                    const float ksa = bf_lo(rk[tt]) * iea, ksb = bf_hi(rk[tt]) * ieb;
                    *(unsigned*)(QSy + (8 * w + tt) * 136 + d2) = cvt_pk_bf16(bf_lo(rq[tt]) * ea, bf_hi(rq[tt]) * eb);
                    *(unsigned*)(KS + (8 * w + tt) * 136 + d2) = cvt_pk_bf16(ksa, ksb);
                    kda[tt] = ksa * eta; kdb[tt] = ksb * etb; }
                u32x4 ka, kb;
                ka.x = cvt_pk_bf16(kda[0], kda[1]); ka.y = cvt_pk_bf16(kda[2], kda[3]); ka.z = cvt_pk_bf16(kda[4], kda[5]); ka.w = cvt_pk_bf16(kda[6], kda[7]);
                kb.x = cvt_pk_bf16(kdb[0], kdb[1]); kb.y = cvt_pk_bf16(kdb[2], kdb[3]); kb.z = cvt_pk_bf16(kdb[4], kdb[5]); kb.w = cvt_pk_bf16(kdb[6], kdb[7]);
                *(u32x4*)(KDy + d2 * 72 + 8 * w) = ka; *(u32x4*)(KDy + (d2 + 1) * 72 + 8 * w) = kb;
                if (pref) { const size_t co = (size_t)(cnn * 64) * NZ1;
#pragma unroll
                    for (int tt = 0; tt < 8; ++tt) { const size_t o = co + (size_t)tt * NZ1; rq[tt] = *(const unsigned*)(zq + o); rk[tt] = *(const unsigned*)(zk + o); } }
            }
            LBAR();
            if (cons) {
                bf16x8 pp0[4], pp1[4];
                const bf16x8 v0 = *(const bf16x8*)(VTx + (16 * w + r) * 72 + 8 * q), v1 = *(const bf16x8*)(VTx + (16 * w + r) * 72 + 32 + 8 * q);
#pragma unroll
                for (int tb = 0; tb < 4; ++tb) { pp0[tb] = *(const bf16x8*)(PPx + (16 * tb + r) * 72 + 8 * q); pp1[tb] = *(const bf16x8*)(PPx + (16 * tb + r) * 72 + 32 + 8 * q); }
                GLA_WAIT();
#pragma unroll
                for (int tb = 0; tb < 4; ++tb) { O[tb] = __builtin_amdgcn_mfma_f32_16x16x32_bf16(pp0[tb], v0, O[tb], 0, 0, 0); O[tb] = __builtin_amdgcn_mfma_f32_16x16x32_bf16(pp1[tb], v1, O[tb], 0, 0, 0); }
                bf16_t* op = og + (size_t)(c * 64) * DM;
#pragma unroll
                for (int tb = 0; tb < 4; ++tb)
#pragma unroll
                    for (int i = 0; i < 4; ++i) op[(size_t)(16 * tb + 4 * q + i) * DM] = attn::f2bf_rne(O[tb][i]);
            }
            if (prod) {
                const int tb = w >> 1; f32x4 p0 = (f32x4){0.f, 0.f, 0.f, 0.f}, p1 = p0;
                bf16x8 pa[4], pb0[4], pb1[4];
#pragma unroll
                for (int kk = 0; kk < 4; ++kk) { pa[kk] = *(const bf16x8*)(QSy + (16 * tb + r) * 136 + 32 * kk + 8 * q);
                    pb0[kk] = *(const bf16x8*)(KS + (32 * (w & 1) + r) * 136 + 32 * kk + 8 * q); pb1[kk] = *(const bf16x8*)(KS + (32 * (w & 1) + 16 + r) * 136 + 32 * kk + 8 * q); }
                GLA_WAIT();
#pragma unroll
                for (int kk = 0; kk < 4; ++kk) { p0 = __builtin_amdgcn_mfma_f32_16x16x32_bf16(pa[kk], pb0[kk], p0, 0, 0, 0); p1 = __builtin_amdgcn_mfma_f32_16x16x32_bf16(pa[kk], pb1[kk], p1, 0, 0, 0); }
                const int j0 = 32 * (w & 1) + r, j1 = j0 + 16;
#pragma unroll
                for (int i = 0; i < 4; ++i) { const int it = 16 * tb + 4 * q + i;
                    const bool k0 = dir ? (j0 > it) : (j0 <= it), k1 = dir ? (j1 > it) : (j1 <= it);
                    PPy[it * 72 + j0] = attn::f2bf_rne(k0 ? p0[i] : 0.f); PPy[it * 72 + j1] = attn::f2bf_rne(k1 ? p1[i] : 0.f); }
            }
            LBAR();
        }
    }
#undef GLA_WAIT
}

__device__ __forceinline__ void attn_phase(unsigned char* lds, const bf16_t* Z2, bf16_t* OA, const float* __restrict__ qg, int bi, int nb, int nunits) {
    for (int u0 = bi, i_ = 0; u0 < nunits; u0 += nb, ++i_) {
        int u = u0;
        if (nunits == 512 && nb == 128) { const int x = bi & 3, t = i_ * 32 + (bi >> 2), bk = x * 4 + (t >> 5);
            u = ((bk >> 1) << 6) | ((((bk & 1) << 2) | ((t >> 3) & 3)) << 3) | (t & 7); }
        const int qb = u & 7, hq = (u >> 3) & 7, b = u >> 6, kvh = hq >> 2;
        const size_t row0 = (size_t)b * SEQ;
        const attn::bf16* Qb = (const attn::bf16*)(Z2 + (row0 + qb * 256) * NZ2 + hq * 128);
        const attn::bf16* Kh = (const attn::bf16*)(Z2 + row0 * NZ2 + 1024 + kvh * 128);
        const attn::bf16* Vh = (const attn::bf16*)(Z2 + row0 * NZ2 + 1280 + kvh * 128);
        attn::attn_dense_body<attn::bf16>(Qb, Kh, Vh, OA + (row0 + qb * 256) * DM + hq * 128, SEQ, (char*)lds, qg, qb * 256);
        __syncthreads();
    }
}

constexpr int NPHASE = 17;
struct Args { const float* in[22]; float* out; unsigned char* ws; int ph_lo, ph_hi; };

__global__ void __launch_bounds__(512, 2) mk_fwd(Args a) {
    extern __shared__ __attribute__((aligned(16))) unsigned char lds[];
    cg::grid_group grid = cg::this_grid();
    PG8_LAS unsigned char* llds = (PG8_LAS unsigned char*)lds;
    unsigned char* ws = a.ws;
    bf16_t* W1IN = (bf16_t*)(ws + WS_W1IN); bf16_t* W1OUT = (bf16_t*)(ws + WS_W1OUT); bf16_t* WIN = (bf16_t*)(ws + WS_WIN);
    bf16_t* WA = (bf16_t*)(ws + WS_WA); bf16_t* WB = (bf16_t*)(ws + WS_WB); bf16_t* WO = (bf16_t*)(ws + WS_WO);
    bf16_t* W2IN = (bf16_t*)(ws + WS_W2IN); bf16_t* W2OUT = (bf16_t*)(ws + WS_W2OUT);
    const int G = gridDim.x, bx = blockIdx.x, GG = G >> 1;
    constexpr int TG = T / 2;
#define GV() int bxo_ = blockIdx.x; asm volatile("" : "+s"(bxo_)); const int grp = bxo_ & 1, gi = ((bxo_ >> 3) << 2) | ((bxo_ & 7) >> 1); const size_t R0 = (size_t)grp * TG; \
    bf16_t* XN = (bf16_t*)(ws + WS_XN) + R0 * DM; bf16_t* FB = (bf16_t*)(ws + WS_F) + R0 * DM; bf16_t* OG = (bf16_t*)(ws + WS_OG) + R0 * DM; \
    bf16_t* ZB = (bf16_t*)(ws + WS_Z + (size_t)grp * (128 * MiB)); bf16_t* HP = (bf16_t*)(a.out + R0 * DM); float* OUTF = a.out + R0 * DM; float* RN = (float*)(ws + WS_RN) + R0; \
    (void)gi; (void)XN; (void)FB; (void)OG; (void)ZB; (void)HP; (void)OUTF; (void)RN
    volatile LAS unsigned* xst = (volatile LAS unsigned*)(llds + (LDS_BYTES - 16));
    if (threadIdx.x < 4) xst[threadIdx.x] = 0u;
    __syncthreads();
    { GV(); (void)xcd_barrier_post((unsigned*)(ws + WS_CTL), xst); (void)xcd_barrier_post((unsigned*)(ws + WS_CTL) + (1 + grp) * 4096, xst + 2); }
    if (a.ph_lo < 0) grid.sync();
#define BAR_ALL() do { XcdBarrier xb_; xb_.bar = (unsigned*)(ws + WS_CTL); xb_.x = xb_xcc_id(); xb_.gsz = (unsigned)G; xb_.st = xst; xcd_barrier(xb_); } while (0)
#define SEAM() do { XcdBarrier xb_; xb_.bar = (unsigned*)(ws + WS_CTL) + (1 + (blockIdx.x & 1)) * 4096; xb_.x = xb_xcc_id(); xb_.gsz = (unsigned)GG; xb_.st = xst + 2; xcd_barrier(xb_); } while (0)
    using namespace pg8;
    { int tl = 0;
      cvt_job(tl, a.in[2], 2 * FF, DM, W1IN, 2 * FF, CM_SWIGLU, a.in[1], nullptr, nullptr, bx, G);
      rows_prenorm(a.in[0], (bf16_t*)(ws + WS_XN), (float*)(ws + WS_RN), bx, G, T); }
    BAR_ALL();
    if ((blockIdx.x & 1) == 1) { GV(); int tl = 0;
      cvt_job(tl, a.in[3], DM, FF, W1OUT, DM, CM_ID, nullptr, nullptr, nullptr, gi, GG);
      cvt_job(tl, a.in[6], NWIN, DM, WIN, 3072, CM_WIN_A, a.in[5], nullptr, nullptr, gi, GG);
      cvt_job(tl, a.in[6], NWIN, DM, WIN + (size_t)3072 * DM, 1024, CM_FOLD, a.in[5], a.in[7], a.in[9], gi, GG);
      cvt_job(tl, a.in[6], NWIN, DM, WIN + (size_t)4096 * DM, NZ2, CM_WIN_B, a.in[5], nullptr, nullptr, gi, GG);
      cvt_job(tl, a.in[12], DM, DM, WA, DM, CM_ID, nullptr, nullptr, nullptr, gi, GG);
      cvt_job(tl, a.in[15], DM, DM, WB, DM, CM_ID, nullptr, nullptr, nullptr, gi, GG);
      cvt_job(tl, a.in[16], DM, DM, WO, DM, CM_ID, nullptr, nullptr, nullptr, gi, GG);
      cvt_job(tl, a.in[19], 2 * FF, DM, W2IN, 2 * FF, CM_SWIGLU, a.in[18], nullptr, nullptr, gi, GG);
      cvt_job(tl, a.in[20], DM, FF, W2OUT, DM, CM_ID, nullptr, nullptr, nullptr, gi, GG);
      SEAM();
      if (threadIdx.x == 0) __hip_atomic_fetch_add((unsigned*)(ws + WS_CTL) + 3 * 4096, 1u, __ATOMIC_RELAXED, __HIP_MEMORY_SCOPE_AGENT);
    }
    { GV(); Gemm g{XN, W1IN, TG, 2 * FF, DM}; StaticOrder S; S.init(TG, 2 * FF, GG, gi); EpiSwiglu E{ZB, FF}; gemm_phase<EpiSwiglu, StaticOrder>(llds, g, S, E); }
    SEAM();
    if ((blockIdx.x & 1) == 0) {
        if (threadIdx.x == 0) { unsigned sp = 0; while (__hip_atomic_load((unsigned*)(ws + WS_CTL) + 3 * 4096, __ATOMIC_RELAXED, __HIP_MEMORY_SCOPE_AGENT) < (unsigned)GG && ++sp < (1u << 22)) __builtin_amdgcn_s_sleep(2);
            __builtin_amdgcn_fence(__ATOMIC_ACQUIRE, "agent"); asm volatile("s_waitcnt vmcnt(0)" ::: "memory"); }
        __syncthreads();
    }
    { GV(); Gemm g{ZB, W1OUT, TG, DM, FF}; StaticOrder S; S.init(TG, DM, GG, gi); EpiAct E{FB, DM, 0, nullptr, nullptr}; gemm_phase<EpiAct, StaticOrder>(llds, g, S, E); }
    SEAM();
    { GV(); rows_resnorm<2, true>(FB, XN, a.in[4], 0.5f, HP, XN, RN, gi, GG, TG); }
    SEAM();
    { GV(); Gemm g{XN, WIN, TG, NZ1, DM}; StaticOrder S; S.init(TG, NZ1, GG, gi); EpiAct E{ZB, NZ1, 1, a.in[8], a.in[10]}; gemm_phase<EpiAct, StaticOrder>(llds, g, S, E); }
    SEAM();
    { GV(); gla_phase(lds, ZB, OG, FB, gi, GG, 128); }
    SEAM();
    { GV(); rows_gla_merge(OG, FB, ZB, a.in[11], gi, GG, TG); }
    SEAM();
    { GV(); Gemm g{XN, WIN + (size_t)4096 * DM, TG, NZ2, DM}; StaticOrder S; S.init(TG, NZ2, GG, gi); EpiAct E{ZB, NZ2, 2, nullptr, nullptr}; gemm_phase<EpiAct, StaticOrder>(llds, g, S, E); }
    SEAM();
    { GV(); rows_rope(ZB, a.in[13], a.in[14], gi, GG, TG); }
    SEAM();
    { GV(); attn_phase(lds, ZB, XN, a.in[13], gi, GG, 512); }
    SEAM();
    { GV(); Gemm g{OG, WA, TG, DM, DM}; StaticOrder S; S.init(TG, DM, GG, gi); EpiGate<false> E{FB, DM, ZB + 1536, NZ2}; gemm_phase<EpiGate<false>, StaticOrder>(llds, g, S, E); }
    { GV(); Gemm g{XN, WB, TG, DM, DM}; StaticOrder S; S.init(TG, DM, GG, gi); EpiGate<true> E{FB, DM, ZB + 2560, NZ2}; gemm_phase<EpiGate<true>, StaticOrder>(llds, g, S, E); }
    SEAM();
    { GV(); Gemm g{FB, WO, TG, DM, DM}; StaticOrder S; S.init(TG, DM, GG, gi); EpiAct E{ZB, DM, 0, nullptr, nullptr}; gemm_phase<EpiAct, StaticOrder>(llds, g, S, E); }
    SEAM();
    { GV(); rows_resnorm<1, true>(ZB, HP, a.in[17], 1.0f, OG, XN, nullptr, gi, GG, TG); }
    SEAM();
    { GV(); Gemm g{XN, W2IN, TG, 2 * FF, DM}; StaticOrder S; S.init(TG, 2 * FF, GG, gi); EpiSwiglu E{ZB, FF}; gemm_phase<EpiSwiglu, StaticOrder>(llds, g, S, E); }
    SEAM();
    { GV(); Gemm g{ZB, W2OUT, TG, DM, FF}; StaticOrder S; S.init(TG, DM, GG, gi); EpiAct E{FB, DM, 0, nullptr, nullptr}; gemm_phase<EpiAct, StaticOrder>(llds, g, S, E); }
    SEAM();
    if ((blockIdx.x & 1) == 1) {
        if (threadIdx.x == 0) __hip_atomic_fetch_add((unsigned*)(ws + WS_CTL) + 3 * 4096 + 64, 1u, __ATOMIC_RELAXED, __HIP_MEMORY_SCOPE_AGENT);
        { GV(); rows_resnorm<1, false>(FB, OG, a.in[21], 0.5f, OUTF, nullptr, nullptr, (int)blockIdx.x, G, TG); }
    } else {
        { GV(); rows_resnorm<1, false>(FB, OG, a.in[21], 0.5f, OUTF, nullptr, nullptr, gi, GG, TG); }
        if (threadIdx.x == 0) { unsigned sp = 0; while (__hip_atomic_load((unsigned*)(ws + WS_CTL) + 3 * 4096 + 64, __ATOMIC_RELAXED, __HIP_MEMORY_SCOPE_AGENT) < (unsigned)GG && ++sp < (1u << 22)) __builtin_amdgcn_s_sleep(2);
            __builtin_amdgcn_fence(__ATOMIC_ACQUIRE, "agent"); asm volatile("s_waitcnt vmcnt(0)" ::: "memory"); }
        __syncthreads();
        { const size_t R1_ = (size_t)TG * DM;
          rows_resnorm<1, false>((bf16_t*)(ws + WS_F) + R1_, (bf16_t*)(ws + WS_OG) + R1_, a.in[21], 0.5f, a.out + R1_, nullptr, nullptr, (int)blockIdx.x, G, TG); }
    }
#undef BAR_ALL
#undef GV
#undef SEAM
}
}

extern "C" void kernel_launch(void* const* d_in, const int* in_sizes, int n_in, void* d_out, int out_size, void* d_ws, size_t ws_size, hipStream_t stream) {
    static int grid = 0;
    if (grid == 0) {
        if (n_in != 22 || in_sizes[0] != mk::T * mk::DM || out_size != mk::T * mk::DM || ws_size < mk::WS_END) {
            fprintf(stderr, "kernel_launch: built for 22 inputs, x/out of %d floats, >= %zu bytes of workspace; got n_in %d in0 %d out %d ws %zu\n", mk::T * mk::DM, (size_t)mk::WS_END, n_in, n_in > 0 ? in_sizes[0] : -1, out_size, ws_size);
            grid = -1; return; }
        int dev = 0, cus = 0, per_cu = 0;
        hipGetDevice(&dev); hipDeviceGetAttribute(&cus, hipDeviceAttributeMultiprocessorCount, dev);
        if (hipFuncSetAttribute((const void*)mk::mk_fwd, hipFuncAttributeMaxDynamicSharedMemorySize, mk::LDS_BYTES) != hipSuccess) { fprintf(stderr, "kernel_launch: hipFuncSetAttribute failed\n"); grid = -1; return; }
        if (hipOccupancyMaxActiveBlocksPerMultiprocessor(&per_cu, (const void*)mk::mk_fwd, 512, mk::LDS_BYTES) != hipSuccess || per_cu < 1) { fprintf(stderr, "kernel_launch: occupancy query says %d blocks per CU\n", per_cu); per_cu = 1; }
        (void)hipGetLastError();
        grid = cus;
        if (grid != 256) { fprintf(stderr, "kernel_launch: this build needs exactly 256 CUs (got %d)\n", grid); grid = -1; return; }
        fprintf(stderr, "kernel_launch: cus %d per_cu %d grid %d ws %zu\n", cus, per_cu, grid, ws_size);
    }
    if (grid < 0) return;
    mk::Args a{};
    for (int i = 0; i < 22; ++i) a.in[i] = (const float*)d_in[i];
    a.out = (float*)d_out; a.ws = (unsigned char*)d_ws;
    if (hipMemsetAsync((char*)d_ws + mk::WS_CTL, 0, 65536, stream) != hipSuccess) { fprintf(stderr, "kernel_launch: hipMemsetAsync failed\n"); return; }
#if MK_PER_PHASE
    for (int p = 0; p < mk::NPHASE; ++p) { a.ph_lo = p; a.ph_hi = p + 1; hipLaunchKernelGGL(mk::mk_fwd, dim3(grid), dim3(512), mk::LDS_BYTES, stream, a); }
#else
    a.ph_lo = 0; a.ph_hi = mk::NPHASE;
    void* args[] = {&a};
    hipError_t e = hipLaunchCooperativeKernel((const void*)mk::mk_fwd, dim3(grid), dim3(512), args, mk::LDS_BYTES, stream);
    if (e != hipSuccess) fprintf(stderr, "kernel_launch: cooperative launch failed: %s (grid %d)\n", hipGetErrorString(e), grid);
#endif
}
```
